# Optimizing an MI355X kernel written in HIP

```python
import math
import jax, jax.numpy as jnp
from jax import lax
import numpy as np

D_MODEL = 1024
BATCH = 8
SEQ = 2048
DEPTH = 4

SSM_WIDTH = D_MODEL // 2
SSM_GROUP = 16
SSM_GROUPS = SSM_WIDTH // SSM_GROUP
SSM_STATE = 64
POOL_WIDTH = D_MODEL // 2
POOL_WINDOWS = (2, 4, 8, 16)
POOL_GROUP = POOL_WIDTH // len(POOL_WINDOWS)
HEAD_DIM = 64
N_HEADS = (D_MODEL // 2) // HEAD_DIM
N_KV_HEADS = 2
GQA_GROUP = N_HEADS // N_KV_HEADS
ATTN_WIDTH = N_HEADS * HEAD_DIM
KV_WIDTH = N_KV_HEADS * HEAD_DIM
BRANCH_WIDTH = D_MODEL // 2
N_BRANCH = 3
CMP_BLOCK = 32
CMP_STRIDE = 16
CMP_HIDDEN = 256
SEL_BLOCK = 64
SEL_TOP = 16
WINDOW = 512
Q_BLOCK = 64
ROPE_THETA = 10000.0
FF_HIDDEN = -(-8 * D_MODEL // (3 * 256)) * 256
DEEPNORM_ALPHA = (2 * DEPTH) ** 0.25
DEEPNORM_BETA = (8 * DEPTH) ** -0.25
LN_EPS = 1e-5
NEG = -1e30
IN_SIZES = (SSM_WIDTH, POOL_WIDTH, ATTN_WIDTH) + (KV_WIDTH,) * 6 + (3 * N_HEADS, N_BRANCH * D_MODEL)
IN_WIDTH = sum(IN_SIZES)
IN_OFFSETS = tuple(sum(IN_SIZES[:i + 1]) for i in range(len(IN_SIZES) - 1))

kernel_name = 'hybrid_s5_pool_nsa_deepnorm'


def layer_norm(x, g, b):
    xf = x.astype(jnp.float32)
    mu = jnp.mean(xf, -1, keepdims=True)
    var = jnp.mean(jnp.square(xf - mu), -1, keepdims=True)
    return ((xf - mu) * lax.rsqrt(var + LN_EPS) * g + b).astype(x.dtype)


def rope(x, positions):
    inv = ROPE_THETA ** (-jnp.arange(0, HEAD_DIM, 2, dtype=jnp.float32) / HEAD_DIM)
    ang = positions.astype(jnp.float32)[..., None] * inv
    cos = jnp.cos(ang)[:, :, None, :]
    sin = jnp.sin(ang)[:, :, None, :]
    x1, x2 = jnp.split(x.astype(jnp.float32), 2, axis=-1)
    return jnp.concatenate([x1 * cos - x2 * sin, x1 * sin + x2 * cos], -1).astype(x.dtype)


def masked_softmax(s, mask):
    s = jnp.where(mask, s.astype(jnp.float32), NEG)
    return jax.nn.softmax(s, axis=-1) * mask


def s5_mixer(u, a_re, a_im, log_dt, b_re, b_im, c_re, c_im, d_skip, w_glu):
    bsz, s, _ = u.shape
    f32 = jnp.float32
    uf = u.astype(f32).reshape(bsz, s, SSM_GROUPS, SSM_GROUP)
    lam = lax.complex(a_re.astype(f32), a_im.astype(f32))
    dt = jnp.exp(log_dt.astype(f32))[:, None]
    lam_bar = jnp.exp(lam * dt)
    b_bar = ((lam_bar - 1.0) / lam)[..., None] * lax.complex(b_re.astype(f32), b_im.astype(f32))
    bu = jnp.einsum('bsgc,gpc->bsgp', uf, b_bar)
    a = jnp.broadcast_to(lam_bar, bu.shape)

    def combine(left, right):
        a1, b1 = left
        a2, b2 = right
        return a1 * a2, a2 * b1 + b2

    _, h = lax.associative_scan(combine, (a, bu), axis=1)
    c = lax.complex(c_re.astype(f32), c_im.astype(f32))
    y = jnp.einsum('bsgp,gcp->bsgc', h, c).real + d_skip.astype(f32).reshape(SSM_GROUPS, SSM_GROUP) * uf
    y = jax.nn.gelu(y.reshape(bsz, s, SSM_WIDTH)).astype(u.dtype)
    val, gate = jnp.split(y @ w_glu, 2, axis=-1)
    return val * jax.nn.sigmoid(gate)


def pool_mixer(u, w_pool, pool_scale):
    bsz, s, _ = u.shape
    uf = u.astype(jnp.float32)
    csum = jnp.pad(jnp.cumsum(uf, axis=1), ((0, 0), (1, 0), (0, 0)))
    t = jnp.arange(s)
    outs = []
    for gi, w in enumerate(POOL_WINDOWS):
        sl = slice(gi * POOL_GROUP, (gi + 1) * POOL_GROUP)
        lo = jnp.maximum(t + 1 - w, 0)
        cnt = (t + 1 - lo).astype(jnp.float32)[None, :, None]
        mean = (csum[:, 1:, sl] - csum[:, lo, sl]) / cnt
        outs.append(mean - uf[:, :, sl])
    pooled = jnp.stack(outs, axis=2).astype(u.dtype)
    mixed = jnp.einsum('bsgc,gcd->bsgd', pooled, w_pool).reshape(bsz, s, POOL_WIDTH)
    return mixed * pool_scale


def nsa_mixer(q, k_cmp, v_cmp, k_sel, v_sel, k_win, v_win, gates, positions, cmp_pos, cmp_w1, cmp_b1, cmp_w2):
    bsz, s, _ = q.shape
    f32 = jnp.float32
    scale = HEAD_DIM ** -0.5
    t = jnp.arange(s)
    heads = lambda z: z.reshape(bsz, s, N_KV_HEADS, HEAD_DIM)
    q = rope(q.reshape(bsz, s, N_HEADS, HEAD_DIM), positions)
    qg = q.reshape(bsz, s, N_KV_HEADS, GQA_GROUP, HEAD_DIM)
    k_cmp = rope(heads(k_cmp), positions)
    v_cmp = heads(v_cmp)
    k_sel = rope(heads(k_sel), positions)
    v_sel = heads(v_sel)
    k_win = rope(heads(k_win), positions)
    v_win = heads(v_win)

    n_cmp = (s - CMP_BLOCK) // CMP_STRIDE + 1
    starts = jnp.arange(n_cmp) * CMP_STRIDE
    blk_idx = starts[:, None] + jnp.arange(CMP_BLOCK)[None, :]

    def compress(z, j):
        zb = z[:, blk_idx] + cmp_pos[j][None, None, :, None, :]
        zb = zb.transpose(0, 1, 3, 2, 4).reshape(bsz, n_cmp, N_KV_HEADS, CMP_BLOCK * HEAD_DIM)
        return jax.nn.gelu(zb @ cmp_w1[j] + cmp_b1[j]) @ cmp_w2[j]

    kc = compress(k_cmp, 0)
    vc = compress(v_cmp, 1)
    s_cmp = jnp.einsum('bshgd,bnhd->bhgsn', qg, kc, preferred_element_type=f32) * scale
    cmp_mask = (starts + CMP_BLOCK - 1)[None, :] <= t[:, None]
    p_cmp = masked_softmax(s_cmp, cmp_mask)
    o_cmp = jnp.einsum('bhgsn,bnhd->bshgd', p_cmp.astype(vc.dtype), vc)

    n_sel = s // SEL_BLOCK
    n_top = min(SEL_TOP, n_sel)
    sel_starts = jnp.arange(n_sel) * SEL_BLOCK
    overlap = jnp.clip(jnp.minimum(starts[:, None] + CMP_BLOCK, sel_starts[None, :] + SEL_BLOCK)
                       - jnp.maximum(starts[:, None], sel_starts[None, :]), 0).astype(f32) / CMP_BLOCK
    imp = jnp.einsum('bhgsn,nj->bhsj', p_cmp, overlap)
    cur = t // SEL_BLOCK
    jb = jnp.arange(n_sel)[None, :]
    forced = (jb == 0) | (jb == cur[:, None]) | (jb == cur[:, None] - 1)
    causal = sel_starts[None, :] <= t[:, None]
    score = jnp.where(forced, 1e30, jnp.where(causal, imp, NEG))
    top_val, top_idx = lax.top_k(score, n_top)
    top_ok = top_val > -1e29

    ks_blocks = k_sel.reshape(bsz, n_sel, SEL_BLOCK, N_KV_HEADS, HEAD_DIM).transpose(0, 3, 1, 2, 4)
    vs_blocks = v_sel.reshape(bsz, n_sel, SEL_BLOCK, N_KV_HEADS, HEAD_DIM).transpose(0, 3, 1, 2, 4)
    k_pad = jnp.pad(k_win, ((0, 0), (WINDOW, 0), (0, 0), (0, 0)))
    v_pad = jnp.pad(v_win, ((0, 0), (WINDOW, 0), (0, 0), (0, 0)))
    b_ix = jnp.arange(bsz)[:, None, None, None]
    h_ix = jnp.arange(N_KV_HEADS)[None, :, None, None]
    n_keys = n_top * SEL_BLOCK

    def query_block(i):
        s0 = i * Q_BLOCK
        tq = s0 + jnp.arange(Q_BLOCK)
        qb = lax.dynamic_slice_in_dim(qg, s0, Q_BLOCK, axis=1)
        idx = lax.dynamic_slice_in_dim(top_idx, s0, Q_BLOCK, axis=2)
        ok = lax.dynamic_slice_in_dim(top_ok, s0, Q_BLOCK, axis=2)
        kg = ks_blocks[b_ix, h_ix, idx].reshape(bsz, N_KV_HEADS, Q_BLOCK, n_keys, HEAD_DIM)
        vg = vs_blocks[b_ix, h_ix, idx].reshape(bsz, N_KV_HEADS, Q_BLOCK, n_keys, HEAD_DIM)
        key_pos = idx[..., None] * SEL_BLOCK + jnp.arange(SEL_BLOCK)
        m_sel = (ok[..., None] & (key_pos <= tq[None, None, :, None, None])).reshape(bsz, N_KV_HEADS, 1, Q_BLOCK, n_keys)
        sc = jnp.einsum('bqhgd,bhqkd->bhgqk', qb, kg, preferred_element_type=f32) * scale
        p = masked_softmax(sc, m_sel)
        o_sel = jnp.einsum('bhgqk,bhqkd->bqhgd', p.astype(vg.dtype), vg)
        kw = lax.dynamic_slice_in_dim(k_pad, s0, WINDOW + Q_BLOCK, axis=1)
        vw = lax.dynamic_slice_in_dim(v_pad, s0, WINDOW + Q_BLOCK, axis=1)
        kpos = s0 - WINDOW + jnp.arange(WINDOW + Q_BLOCK)
        diff = tq[:, None] - kpos[None, :]
        m_win = (kpos[None, :] >= 0) & (diff >= 0) & (diff < WINDOW)
        sc = jnp.einsum('bqhgd,bkhd->bhgqk', qb, kw, preferred_element_type=f32) * scale
        p = masked_softmax(sc, m_win)
        o_win = jnp.einsum('bhgqk,bkhd->bqhgd', p.astype(vw.dtype), vw)
        return o_sel, o_win

    o_sel, o_win = lax.map(query_block, jnp.arange(s // Q_BLOCK))
    o_sel = o_sel.transpose(1, 0, 2, 3, 4, 5).reshape(bsz, s, N_KV_HEADS, GQA_GROUP, HEAD_DIM)
    o_win = o_win.transpose(1, 0, 2, 3, 4, 5).reshape(bsz, s, N_KV_HEADS, GQA_GROUP, HEAD_DIM)
    g = jax.nn.sigmoid(gates.reshape(bsz, s, 3, N_KV_HEADS, GQA_GROUP, 1))
    out = g[:, :, 0] * o_cmp + g[:, :, 1] * o_sel + g[:, :, 2] * o_win
    return out.reshape(bsz, s, ATTN_WIDTH)


def setup_inputs(seed: int = 0) -> dict:
    key = jax.random.key(seed)
    ks = jax.random.split(key, 24)
    f32 = jnp.float32
    nrm = lambda k, shape, fan_in: jax.random.normal(k, shape, f32) * fan_in ** -0.5
    x = jax.random.normal(ks[0], (BATCH, SEQ, D_MODEL), f32)
    offsets = jax.random.randint(ks[1], (BATCH, 1), 0, 4096, dtype=jnp.int32)
    positions = offsets + jnp.arange(SEQ, dtype=jnp.int32)[None, :]
    w_in = nrm(ks[2], (DEPTH, D_MODEL, IN_WIDTH), D_MODEL)
    ssm_a_re = -0.5 + 0.01 * jax.random.normal(ks[3], (DEPTH, SSM_GROUPS, SSM_STATE), f32)
    ssm_a_im = math.pi * jnp.arange(SSM_STATE, dtype=f32) + 0.01 * jax.random.normal(ks[4], (DEPTH, SSM_GROUPS, SSM_STATE), f32)
    ssm_log_dt = jax.random.uniform(ks[5], (DEPTH, SSM_GROUPS), f32, math.log(1e-3), math.log(1e-1))
    ssm_b_re = nrm(ks[6], (DEPTH, SSM_GROUPS, SSM_STATE, SSM_GROUP), 2 * SSM_GROUP)
    ssm_b_im = nrm(ks[7], (DEPTH, SSM_GROUPS, SSM_STATE, SSM_GROUP), 2 * SSM_GROUP)
    ssm_c_re = nrm(ks[8], (DEPTH, SSM_GROUPS, SSM_GROUP, SSM_STATE), SSM_STATE)
    ssm_c_im = nrm(ks[9], (DEPTH, SSM_GROUPS, SSM_GROUP, SSM_STATE), SSM_STATE)
    ssm_d = jax.random.normal(ks[10], (DEPTH, SSM_WIDTH), f32)
    ssm_w_glu = nrm(ks[11], (DEPTH, SSM_WIDTH, 2 * SSM_WIDTH), SSM_WIDTH)
    pool_w = nrm(ks[12], (DEPTH, len(POOL_WINDOWS), POOL_GROUP, POOL_GROUP), POOL_GROUP)
    pool_scale = 1.0 + 0.02 * jax.random.normal(ks[13], (DEPTH, POOL_WIDTH), f32)
    cmp_pos = 0.02 * jax.random.normal(ks[14], (DEPTH, 2, CMP_BLOCK, HEAD_DIM), f32)
    cmp_w1 = nrm(ks[15], (DEPTH, 2, CMP_BLOCK * HEAD_DIM, CMP_HIDDEN), CMP_BLOCK * HEAD_DIM)
    cmp_b1 = 0.01 * jax.random.normal(ks[16], (DEPTH, 2, CMP_HIDDEN), f32)
    cmp_w2 = nrm(ks[17], (DEPTH, 2, CMP_HIDDEN, HEAD_DIM), CMP_HIDDEN)
    w_branch = nrm(ks[18], (DEPTH, N_BRANCH, BRANCH_WIDTH, D_MODEL), BRANCH_WIDTH)
    w_out = nrm(ks[19], (DEPTH, D_MODEL, D_MODEL), D_MODEL) * DEEPNORM_BETA
    ln_g = 1.0 + 0.02 * jax.random.normal(ks[20], (DEPTH, 2, D_MODEL), f32)
    ln_b = 0.02 * jax.random.normal(ks[21], (DEPTH, 2, D_MODEL), f32)
    ffn_w_in = nrm(ks[22], (DEPTH, D_MODEL, 2 * FF_HIDDEN), D_MODEL)
    ffn_w_out = nrm(ks[23], (DEPTH, FF_HIDDEN, D_MODEL), FF_HIDDEN) * DEEPNORM_BETA
    return {'x': x, 'positions': positions, 'w_in': w_in,
            'ssm_a_re': ssm_a_re, 'ssm_a_im': ssm_a_im, 'ssm_log_dt': ssm_log_dt,
            'ssm_b_re': ssm_b_re, 'ssm_b_im': ssm_b_im, 'ssm_c_re': ssm_c_re, 'ssm_c_im': ssm_c_im,
            'ssm_d': ssm_d, 'ssm_w_glu': ssm_w_glu, 'pool_w': pool_w, 'pool_scale': pool_scale,
            'cmp_pos': cmp_pos, 'cmp_w1': cmp_w1, 'cmp_b1': cmp_b1, 'cmp_w2': cmp_w2,
            'w_branch': w_branch, 'w_out': w_out, 'ln_g': ln_g, 'ln_b': ln_b,
            'ffn_w_in': ffn_w_in, 'ffn_w_out': ffn_w_out}


def reference(x, positions, w_in, ssm_a_re, ssm_a_im, ssm_log_dt, ssm_b_re, ssm_b_im, ssm_c_re, ssm_c_im,
              ssm_d, ssm_w_glu, pool_w, pool_scale, cmp_pos, cmp_w1, cmp_b1, cmp_w2,
              w_branch, w_out, ln_g, ln_b, ffn_w_in, ffn_w_out):
    bsz, s, _ = x.shape
    for l in range(DEPTH):
        proj = x @ w_in[l]
        (u_ssm, u_pool, q, k_c, v_c, k_s, v_s, k_w, v_w, nsa_g, br_g) = jnp.split(proj, IN_OFFSETS, axis=-1)
        y_ssm = s5_mixer(u_ssm, ssm_a_re[l], ssm_a_im[l], ssm_log_dt[l], ssm_b_re[l], ssm_b_im[l],
                         ssm_c_re[l], ssm_c_im[l], ssm_d[l], ssm_w_glu[l])
        y_pool = pool_mixer(u_pool, pool_w[l], pool_scale[l])
        y_nsa = nsa_mixer(q, k_c, v_c, k_s, v_s, k_w, v_w, nsa_g, positions,
                          cmp_pos[l], cmp_w1[l], cmp_b1[l], cmp_w2[l])
        branches = jnp.stack([y_ssm, y_pool, y_nsa], axis=2)
        branch_d = jnp.einsum('bskc,kcd->bskd', branches, w_branch[l])
        gate = jax.nn.sigmoid(br_g.reshape(bsz, s, N_BRANCH, D_MODEL))
        merged = jnp.sum(gate * branch_d, axis=2)
        x = layer_norm(DEEPNORM_ALPHA * x + merged @ w_out[l], ln_g[l, 0], ln_b[l, 0])
        h_gate, h_up = jnp.split(x @ ffn_w_in[l], 2, axis=-1)
        x = layer_norm(DEEPNORM_ALPHA * x + (jax.nn.silu(h_gate) * h_up) @ ffn_w_out[l], ln_g[l, 1], ln_b[l, 1])
    return x
```

```cpp
#include <hip/hip_runtime.h>
#include <hip/hip_cooperative_groups.h>
#include <cstdio>
namespace cg = cooperative_groups;

typedef _Float16 hf;
typedef _Float16 h8 __attribute__((ext_vector_type(8)));
typedef _Float16 h4 __attribute__((ext_vector_type(4)));
typedef float f4 __attribute__((ext_vector_type(4)));
typedef float f2 __attribute__((ext_vector_type(2)));
typedef float f16v __attribute__((ext_vector_type(16)));
#define DEVI __device__ __forceinline__
DEVI int otid() { int t = threadIdx.x; asm volatile("" : "+v"(t)); return t; }
DEVI int obid() { int b = blockIdx.x; asm volatile("" : "+s"(b)); return b; }

constexpr int T_ = 16384, S_ = 2048, DEPTH_ = 4;
constexpr int NIN = 5632;
constexpr int FFH = 2816;
constexpr float ALPHA = 1.6817928305074290f;

constexpr size_t OFF_BTIN = 0;
constexpr size_t OFF_BTFI = OFF_BTIN + (size_t)NIN * 1024 * 2;
constexpr size_t OFF_BTFO = OFF_BTFI + (size_t)NIN * 1024 * 2;
constexpr size_t OFF_BTWO = OFF_BTFO + (size_t)1024 * FFH * 2;
constexpr size_t OFF_BTBR = OFF_BTWO + (size_t)1024 * 1024 * 2;
constexpr size_t OFF_BTGLU = OFF_BTBR + (size_t)1024 * 1536 * 2;
constexpr size_t OFF_BTC1 = OFF_BTGLU + (size_t)1024 * 512 * 2;
constexpr size_t OFF_BTC2 = OFF_BTC1 + (size_t)2 * 256 * 2048 * 2;
constexpr size_t OFF_BTPOOL = OFF_BTC2 + (size_t)2 * 64 * 256 * 2;
constexpr size_t OFF_WC = OFF_BTPOOL + (size_t)4 * 128 * 128 * 2;
constexpr size_t OFF_W1 = OFF_WC + (size_t)32 * 256 * 384 * 2;
constexpr size_t OFF_LAM16 = OFF_W1 + (size_t)32 * 128 * 256 * 2;
constexpr size_t OFF_CB1 = OFF_LAM16 + (size_t)32 * 64 * 8;
constexpr size_t OFF_ROPE = OFF_CB1 + 4096;
constexpr size_t OFF_XH = OFF_ROPE + (size_t)T_ * 32 * 8;
constexpr size_t OFF_SP = OFF_XH;

constexpr size_t OFF_BRG = OFF_XH + (size_t)T_ * 1024 * 2;
constexpr size_t OFF_HFF = OFF_BRG;
constexpr size_t OFF_YBR = OFF_BRG + (size_t)T_ * 3072 * 2;
constexpr size_t OFF_USSM = OFF_YBR + (size_t)T_ * 1536 * 2;
constexpr size_t OFF_UPOOL = OFF_USSM + (size_t)32 * 1024 * 384 * 2;
constexpr size_t OFF_YGELU = OFF_UPOOL;
constexpr size_t OFF_Q = OFF_UPOOL + (size_t)T_ * 512 * 2;
constexpr size_t OFF_KV = OFF_Q + (size_t)T_ * 512 * 2;
constexpr size_t SZ_KV1 = (size_t)2 * T_ * 64 * 2;
constexpr size_t OFF_NSAG = OFF_KV + 6 * SZ_KV1 + 65536;
constexpr size_t OFF_HG = OFF_NSAG + (size_t)T_ * 24 * 4;
constexpr size_t OFF_KCOMP = OFF_HG + (size_t)4 * 1024 * 256 * 2;
constexpr size_t OFF_ETAB = OFF_KCOMP + (size_t)2 * 8 * 2 * 128 * 64 * 2;
constexpr size_t OFF_BAR = OFF_ETAB + (size_t)DEPTH_ * 2048 * 18 * 8;
constexpr size_t OFF_XS = OFF_BAR + 32768;
constexpr size_t OFF_POOLED = OFF_XS + (size_t)64 * 256 * 4 * 8;
constexpr size_t OFF_MERGED = OFF_Q;
constexpr size_t NINA = 2560, NINB = 3072;
constexpr size_t WS_TOTAL = OFF_POOLED + (size_t)T_ * 512 * 2;
static_assert(WS_TOTAL < (size_t)352 * 1024 * 1024, "workspace too large");

struct P {
  const float* x; const int* pos; const float* w_in; const float* a_re; const float* a_im; const float* log_dt;
  const float* b_re; const float* b_im; const float* c_re; const float* c_im; const float* ssm_d; const float* w_glu;
  const float* pool_w; const float* pool_scale; const float* cmp_pos; const float* cmp_w1; const float* cmp_b1; const float* cmp_w2;
  const float* w_branch; const float* w_out; const float* ln_g; const float* ln_b; const float* ffn_w_in; const float* ffn_w_out;
  float* out; char* ws;
};

DEVI float frcp(float x) { return __builtin_amdgcn_rcpf(x); }
DEVI float sigmoidf_(float x) { return frcp(1.0f + __expf(-x)); }
DEVI float gelu_tanh(float x) { const float u = 0.7978845608028654f * (x + 0.044715f * x * x * x); return x * frcp(1.0f + __expf(-2.0f * u)); }
DEVI h4 pack4(f4 v) { h4 r; r[0] = (hf)v[0]; r[1] = (hf)v[1]; r[2] = (hf)v[2]; r[3] = (hf)v[3]; return r; }


#define XB_TMO      128
#define XB_XCNT(j)  (256  + 64 * (j))
#define XB_XSUB(j)  (1280 + 64 * (j))
#define XB_XGEN(j)  (2304 + 64 * (j))
#define XB_TOP      3328
#define XB_TOPGEN   3392
#define XCD_BAR_WORDS 3456
#define XB_SPIN_CAP (1u << 20)
#define LAS __attribute__((address_space(3)))
DEVI unsigned xb_ld(unsigned* p)              { return __hip_atomic_load(p, __ATOMIC_RELAXED, __HIP_MEMORY_SCOPE_AGENT); }
DEVI unsigned xb_add(unsigned* p, unsigned v) { return __hip_atomic_fetch_add(p, v, __ATOMIC_RELAXED, __HIP_MEMORY_SCOPE_AGENT); }
DEVI unsigned xb_xcc_id() { return (unsigned)__builtin_amdgcn_s_getreg((3 << 11) | 20) & 0xFu; }
#define XB_SPIN(cond, bar) do { unsigned _sp = 0; while (cond) { __builtin_amdgcn_s_sleep(1); \
    if ((++_sp & 255u) == 0u) { if (xb_ld(&(bar)[XB_TMO])) break; if (_sp > XB_SPIN_CAP) { atomicAdd(&(bar)[XB_TMO], 1u); break; } } } } while (0)
struct XcdBarrier { unsigned* bar; unsigned x; volatile LAS unsigned* st; };
DEVI XcdBarrier xcd_barrier_post(unsigned* bar, volatile LAS unsigned* st) {
  XcdBarrier b; b.bar = bar; b.x = xb_xcc_id(); b.st = st;
  if (threadIdx.x == 0) (void)xb_add(&bar[XB_XCNT(b.x)], 1u);
  return b;
}
DEVI void xcd_barrier_complete(unsigned* bar, unsigned x, unsigned& nloc, unsigned& nx) {
  const unsigned G = gridDim.x * gridDim.y * gridDim.z;
  unsigned sum, cnt, mine, sp = 0u;
  for (;;) {
    sum = 0u; cnt = 0u; mine = 0u;
#pragma unroll
    for (unsigned j = 0; j < 16; ++j) { const unsigned c = xb_ld(&bar[XB_XCNT(j)]); sum += c; cnt += (c > 0u) ? 1u : 0u; mine = (j == x) ? c : mine; }
    if (sum == G) break;
    __builtin_amdgcn_s_sleep(1);
    if ((++sp & 255u) == 0u) { if (xb_ld(&bar[XB_TMO])) break; if (sp > XB_SPIN_CAP) { atomicAdd(&bar[XB_TMO], 1u); break; } }
  }
  nloc = mine > 0u ? mine : 1u; nx = cnt > 0u ? cnt : 1u;
}
DEVI void xcd_barrier(const XcdBarrier& b) {
  asm volatile("s_waitcnt vmcnt(0)" ::: "memory");
  __syncthreads();
  if (threadIdx.x == 0) {
    unsigned* bar = b.bar;
    __builtin_amdgcn_s_waitcnt(0);
    unsigned nloc = b.st[0], nx = b.st[1];
    if (nloc == 0u) { xcd_barrier_complete(bar, b.x, nloc, nx); b.st[0] = nloc; b.st[1] = nx; }
    const unsigned old = xb_add(&bar[XB_XSUB(b.x)], 1u);
    const unsigned gen = old / nloc;
    if (old + 1u == (gen + 1u) * nloc) {
      __builtin_amdgcn_fence(__ATOMIC_RELEASE, "agent");
      asm volatile("s_waitcnt vmcnt(0)" ::: "memory");
      const unsigned og = xb_add(&bar[XB_TOP], 1u);
      const unsigned tg = og / nx;
      if (og + 1u == (tg + 1u) * nx) xb_add(&bar[XB_TOPGEN], 1u);
      else XB_SPIN(xb_ld(&bar[XB_TOPGEN]) == tg, bar);
      __builtin_amdgcn_fence(__ATOMIC_ACQUIRE, "agent");
      xb_add(&bar[XB_XGEN(b.x)], 1u);
      asm volatile("s_waitcnt vmcnt(0)" ::: "memory");
    } else {
      XB_SPIN(xb_ld(&bar[XB_XGEN(b.x)]) == gen, bar);
      __builtin_amdgcn_fence(__ATOMIC_ACQUIRE, "agent");
      asm volatile("s_waitcnt vmcnt(0)" ::: "memory");
    }
  }
  __syncthreads();
}

constexpr int BM = 256, BK = 64, HALFT = 128, HT = HALFT * BK;
DEVI int lds_byte(int r, int c) { int st = (r >> 4) * 2 + (c >> 5), rr = r & 15, cc = c & 31, ob = rr * 64 + cc * 2; return st * 1024 + (ob ^ (((ob >> 9) & 1) << 5)); }
DEVI void stage_rc(int b, int& R, int& C) { int st = b / 1024, sb = b % 1024, swz = sb ^ (((sb >> 9) & 1) << 5); R = (st >> 1) * 16 + swz / 64; C = (st & 1) * 32 + (swz % 64) / 2; }

struct NoHook { DEVI void operator()(f4 (&)[2][2][4][2], int, int, int, int, int, int, int) const {} };

template <class Epi, class Hook>
DEVI void gemm256(const hf* __restrict__ A, int lda, const hf* __restrict__ Bt, int ldb, int K, int nM, int nN, char* smem, const Epi& epi, const Hook& hook) {
  LAS unsigned char* lds = (LAS unsigned char*)smem;
  constexpr int HTB = HT * 2;
  const int tid = otid(), wid = __builtin_amdgcn_readfirstlane(tid >> 6), lane = tid & 63, wr = wid >> 2, wc = wid & 3, fr = lane & 15, fq = lane >> 4;
  unsigned voffA[2], voffB[2];
#pragma unroll
  for (int i = 0; i < 2; ++i) { int R, C; stage_rc(tid * 16 + i * 8192, R, C); voffA[i] = (unsigned)(R * lda + C) * 2u; voffB[i] = (unsigned)(R * ldb + C) * 2u; }
  const int kstep = BK * 2, hstepA = HALFT * lda * 2, hstepB = HALFT * ldb * 2;
  const __amdgpu_buffer_rsrc_t rA = __builtin_amdgcn_make_buffer_rsrc((void*)A, (short)0, 0x7fffffff, 0x00020000), rB = __builtin_amdgcn_make_buffer_rsrc((void*)Bt, (short)0, 0x7fffffff, 0x00020000);
  const unsigned ldsw = (unsigned)wid * 1024u;
  const int aoff = lds_byte(wr * 64 + fr, fq * 8), boff = lds_byte(wc * 32 + fr, fq * 8);
#define SA(b, h) (((b) * 2 + (h)) * HTB)
#define SB(b, h) ((4 + (b) * 2 + (h)) * HTB)
#define STAGE(bufoff, gbase, voff) do { _Pragma("unroll") for (int _i = 0; _i < 2; ++_i) \
    __builtin_amdgcn_raw_ptr_buffer_load_lds((&(voff)[0] == &voffA[0]) ? rA : rB, (LAS void*)(lds + (bufoff) + ldsw + _i * 8192), 16, (voff)[_i], (int)(gbase), 0, 0); } while (0)
#define LDA(dst, b, h) do { _Pragma("unroll") for (int m = 0; m < 4; ++m) _Pragma("unroll") for (int k = 0; k < 2; ++k) dst[m][k] = *(const LAS h8*)(lds + SA(b, h) + aoff + m * 2048 + k * 1024); } while (0)
#define LDB(dst, b, h) do { _Pragma("unroll") for (int n = 0; n < 2; ++n) _Pragma("unroll") for (int k = 0; k < 2; ++k) dst[n][k] = *(const LAS h8*)(lds + SB(b, h) + boff + n * 2048 + k * 1024); } while (0)
#define MMA(ai, bj, At_, Bt_) do { __builtin_amdgcn_s_setprio(1); \
    _Pragma("unroll") for (int m = 0; m < 4; ++m) _Pragma("unroll") for (int n = 0; n < 2; ++n) _Pragma("unroll") for (int k = 0; k < 2; ++k) \
      acc[ai][bj][m][n] = __builtin_amdgcn_mfma_f32_16x16x32_f16(Bt_[n][k], At_[m][k], acc[ai][bj][m][n], 0, 0, 0); \
    __builtin_amdgcn_s_setprio(0); } while (0)
#define WAIT_V(n) asm volatile("s_waitcnt vmcnt(" #n ")" ::: "memory")
#define WAIT_L(n) asm volatile("s_waitcnt lgkmcnt(" #n ")" ::: "memory")
#define BAR __builtin_amdgcn_s_barrier()
#define SCHED __builtin_amdgcn_sched_barrier(0)
  const int nwg = nM * nN;
  const int nt = K / BK;
  for (int L = obid(); L < nwg; L += gridDim.x) {
    int wgid = L;
    { const int q = nwg / 8, r = nwg % 8, xcd = wgid % 8, off = wgid / 8; wgid = (xcd < r ? xcd * (q + 1) : r * (q + 1) + (xcd - r) * q) + off; }
    const int WG_ = nN >= 16 ? 2 : 4;
    const int nig = WG_ * nN, gid = wgid / nig, fm = gid * WG_, gsz = min(nM - fm, WG_);
    const int pm = fm + ((wgid % nig) % gsz), pn = (wgid % nig) / gsz, brow = pm * BM, bcol = pn * BM;
    const int cA = brow * lda * 2, cB = bcol * ldb * 2;
    __syncthreads();
    f4 acc[2][2][4][2];
#pragma unroll
    for (int a = 0; a < 2; ++a)
#pragma unroll
      for (int b = 0; b < 2; ++b)
#pragma unroll
        for (int m = 0; m < 4; ++m)
#pragma unroll
          for (int n = 0; n < 2; ++n) acc[a][b][m][n] = (f4){0.f, 0.f, 0.f, 0.f};
    h8 At[4][2], B0[2][2], B1[2][2];
    STAGE(SB(0, 0), cB, voffB); STAGE(SA(0, 0), cA, voffA); STAGE(SB(0, 1), cB + hstepB, voffB); STAGE(SA(0, 1), cA + hstepA, voffA);
    if (wr == 1) BAR;
    WAIT_V(4); BAR;
    STAGE(SB(1, 0), cB + kstep, voffB); STAGE(SA(1, 0), cA + kstep, voffA); STAGE(SB(1, 1), cB + hstepB + kstep, voffB);
    WAIT_V(6); BAR;
    for (int t = 0; t < nt - 2; t += 2) {
      hook(acc, t, brow, bcol, wr, wc, fr, fq);
      const int a1 = cA + (t + 1) * kstep, a2 = a1 + kstep, a3 = a2 + kstep;
      const int b2 = cB + (t + 2) * kstep, b3 = b2 + kstep;
      LDB(B0, 0, 0); SCHED; LDA(At, 0, 0); STAGE(SA(1, 1), a1 + hstepA, voffA);
      WAIT_L(8); BAR; WAIT_L(0); MMA(0, 0, At, B0); BAR; SCHED;
      LDB(B1, 0, 1); STAGE(SB(0, 0), b2, voffB);
      BAR; WAIT_L(0); MMA(0, 1, At, B1); BAR;
      LDA(At, 0, 1); STAGE(SA(0, 0), a2, voffA);
      BAR; WAIT_L(0); MMA(1, 0, At, B0); BAR; SCHED;
      STAGE(SB(0, 1), b2 + hstepB, voffB);
      WAIT_V(6); BAR; MMA(1, 1, At, B1); BAR;
      LDB(B0, 1, 0); SCHED; LDA(At, 1, 0); STAGE(SA(0, 1), a2 + hstepA, voffA);
      WAIT_L(8); BAR; WAIT_L(0); MMA(0, 0, At, B0); BAR; SCHED;
      LDB(B1, 1, 1); STAGE(SB(1, 0), b3, voffB);
      BAR; WAIT_L(0); MMA(0, 1, At, B1); BAR;
      LDA(At, 1, 1); STAGE(SA(1, 0), a3, voffA);
      BAR; WAIT_L(0); MMA(1, 0, At, B0); BAR; SCHED;
      STAGE(SB(1, 1), b3 + hstepB, voffB);
      WAIT_V(6); BAR; MMA(1, 1, At, B1); BAR;
    }
    { LDB(B0, 0, 0); LDA(At, 0, 0); STAGE(SA(1, 1), cA + (nt - 1) * kstep + hstepA, voffA);
      BAR; WAIT_L(0); MMA(0, 0, At, B0); BAR;
      LDB(B1, 0, 1); BAR; WAIT_L(0); MMA(0, 1, At, B1); BAR;
      LDA(At, 0, 1); WAIT_V(4); BAR; WAIT_L(0); MMA(1, 0, At, B0); MMA(1, 1, At, B1); BAR; }
    { LDB(B0, 1, 0); LDA(At, 1, 0); WAIT_V(2); BAR; WAIT_L(0); MMA(0, 0, At, B0); BAR;
      LDB(B1, 1, 1); WAIT_V(0); BAR; WAIT_L(0); MMA(0, 1, At, B1); BAR;
      LDA(At, 1, 1); BAR; WAIT_L(0); MMA(1, 0, At, B0); MMA(1, 1, At, B1); BAR; }
    if (wr == 0) BAR;
    { int fr2 = fr, fq2 = fq, brow2 = brow, bcol2 = bcol; asm volatile("" : "+v"(fr2), "+v"(fq2)); asm volatile("" : "+s"(brow2), "+s"(bcol2));
      epi(acc, brow2, bcol2, wr, wc, fr2, fq2); }
  }
#undef SA
#undef SB
}

template <int MT, class AF, class BF, class EF>
DEVI void sgemm_tile(int K, const AF& af, const BF& bf, const EF& ef, char* smem) {
  hf* As = (hf*)smem;
  hf* Bs = As + 64 * MT * 136;
  const int tid = otid(), w = __builtin_amdgcn_readfirstlane(tid >> 6), lane = tid & 63, wr = w >> 1, wc = w & 1, fr = lane & 15, fq = lane >> 4;
  const int lr = tid >> 4, lk = (tid & 15) * 8;
  f4 acc[MT][2];
#pragma unroll
  for (int m = 0; m < MT; ++m)
#pragma unroll
    for (int n = 0; n < 2; ++n) acc[m][n] = (f4){0.f, 0.f, 0.f, 0.f};
  h8 ra[2 * MT], rb[2];
#pragma unroll
  for (int i = 0; i < 2 * MT; ++i) ra[i] = *(const h8*)af(lr + 32 * i, lk);
#pragma unroll
  for (int i = 0; i < 2; ++i) rb[i] = *(const h8*)bf(lr + 32 * i, lk);
  for (int k0 = 0; k0 < K; k0 += 128) {
    __syncthreads();
#pragma unroll
    for (int i = 0; i < 2 * MT; ++i) *(h8*)(As + (lr + 32 * i) * 136 + lk) = ra[i];
#pragma unroll
    for (int i = 0; i < 2; ++i) *(h8*)(Bs + (lr + 32 * i) * 136 + lk) = rb[i];
    __syncthreads();
    if (k0 + 128 < K) {
#pragma unroll
      for (int i = 0; i < 2 * MT; ++i) ra[i] = *(const h8*)af(lr + 32 * i, k0 + 128 + lk);
#pragma unroll
      for (int i = 0; i < 2; ++i) rb[i] = *(const h8*)bf(lr + 32 * i, k0 + 128 + lk);
    }
#pragma unroll
    for (int ks = 0; ks < 4; ++ks) {
      h8 a[MT], b[2];
#pragma unroll
      for (int m = 0; m < MT; ++m) a[m] = *(const h8*)(As + (wr * 16 * MT + m * 16 + fr) * 136 + ks * 32 + fq * 8);
#pragma unroll
      for (int n = 0; n < 2; ++n) b[n] = *(const h8*)(Bs + (wc * 32 + n * 16 + fr) * 136 + ks * 32 + fq * 8);
#pragma unroll
      for (int m = 0; m < MT; ++m)
#pragma unroll
        for (int n = 0; n < 2; ++n) acc[m][n] = __builtin_amdgcn_mfma_f32_16x16x32_f16(b[n], a[m], acc[m][n], 0, 0, 0);
    }
  }
#pragma unroll
  for (int m = 0; m < MT; ++m)
#pragma unroll
    for (int n = 0; n < 2; ++n) ef(wr * 16 * MT + m * 16 + fr, wc * 32 + n * 16 + fq * 4, acc[m][n]);
}

DEVI int srccol(int map, int n) {
  if (map == 0) {
    const int hc = n >> 7, pc = n & 127;
    int lc = pc;
    if ((hc >= 8 && hc <= 12) || hc == 14 || hc == 16) { const int wc = pc >> 5, nn = (pc >> 4) & 1, q = pc & 15; lc = (wc >> 1) * 64 + (wc & 1) * 16 + q + 32 * nn; }
    if (hc < 18) return hc * 128 + lc;
    if (hc == 18) return lc < 24 ? 2304 + lc : -1;
    return -1;
  }
  if (map == 3) return 2328 + n;
  if (map == 1) { const int pn = n >> 8, bj = (n >> 7) & 1, i = n & 127; return bj * 512 + pn * 128 + i; }
  if (map == 2) { const int pn = n >> 8, bj = (n >> 7) & 1, i = n & 127; return bj * FFH + pn * 128 + i; }
  return n;
}

DEVI void tconv(const float* __restrict__ src, int ldS, hf* __restrict__ dst, int ldD, int Kr, int Np, int map, int& rot, char* smem) {
  hf* tl = (hf*)smem;
  const int nkt = Kr / 64, nnt = Np / 64, tid = otid(), ntl = nkt * nnt;
  const int G = gridDim.x;
  const int first = (int)((obid() + G - (rot % G)) % G);
  rot += ntl;
  for (int tIdx = first; tIdx < ntl; tIdx += G) {
    const int kt = tIdx % nkt, ntile = tIdx / nkt;
    const int n = tid & 63, kk = tid >> 6;
    const int sc = srccol(map, ntile * 64 + n);
    __syncthreads();
#pragma unroll
    for (int i = 0; i < 8; ++i) { const int k = i * 8 + kk; const float v = sc >= 0 ? src[(size_t)(kt * 64 + k) * ldS + sc] : 0.f; tl[k * 66 + n] = (hf)v; }
    __syncthreads();
    const int n2 = tid >> 3, k8 = (tid & 7) * 8;
    h8 o;
#pragma unroll
    for (int i = 0; i < 8; ++i) o[i] = tl[(k8 + i) * 66 + n2];
    *(h8*)(dst + (size_t)(ntile * 64 + n2) * ldD + kt * 64 + k8) = o;
  }
}

DEVI void tconv_big(const float* __restrict__ src, int ldS, hf* __restrict__ dst, int ldD, int Kr, int Np, int map, int& rot, char* smem) {
  hf* tl = (hf*)smem;
  const int nkt = Kr / 64, nnt = Np / 256, tid = otid(), ntl = nkt * nnt;
  const int G = gridDim.x;
  const int first = (int)((obid() + G - (rot % G)) % G);
  rot += ntl;
  for (int tIdx = first; tIdx < ntl; tIdx += G) {
    const int kt = tIdx % nkt, ntile = tIdx / nkt;
    const int n4 = (tid & 63) * 4, kk = tid >> 6;
    const int sc = srccol(map, ntile * 256 + n4);
    f4 v[8];
#pragma unroll
    for (int i = 0; i < 8; ++i) v[i] = sc >= 0 ? *(const f4*)(src + (size_t)(kt * 64 + i * 8 + kk) * ldS + sc) : (f4){0.f, 0.f, 0.f, 0.f};
    __syncthreads();
#pragma unroll
    for (int i = 0; i < 8; ++i) *(h4*)(tl + (i * 8 + kk) * 264 + n4) = pack4(v[i]);
    __syncthreads();
#pragma unroll
    for (int q = 0; q < 4; ++q) {
      const int n2 = (tid >> 3) + q * 64, k8 = (tid & 7) * 8;
      h8 o;
#pragma unroll
      for (int i = 0; i < 8; ++i) o[i] = tl[(k8 + i) * 264 + n2];
      *(h8*)(dst + (size_t)(ntile * 256 + n2) * ldD + kt * 64 + k8) = o;
    }
  }
}

DEVI void lampow(float ar, float ai, double dt, int n, double& re, double& im) {
  const double m = exp((double)ar * dt * n), ang = (double)ai * dt * n;
  re = m * cos(ang); im = m * sin(ang);
}
DEVI void zohcoef(float ar, float ai, double dt, double& re, double& im) {
  double lr, li; lampow(ar, ai, dt, 1, lr, li);
  const double nr = lr - 1.0, ni = li, dr = (double)ar, di = (double)ai, den = dr * dr + di * di;
  re = (nr * dr + ni * di) / den; im = (ni * dr - nr * di) / den;
}

DEVI void w_ffo(const P& p, int l, char* smem) {
  int rot = 0;
  tconv_big(p.ffn_w_out + (size_t)l * FFH * 1024, 1024, (hf*)(p.ws + OFF_BTFO), FFH, FFH, 1024, 9, rot, smem);
}
DEVI void phase_w(const P& p, int l, char* smem) {
  char* ws = p.ws;
  int rot = 0;
  tconv_big(p.w_in + (size_t)l * 1024 * 5400, 5400, (hf*)(ws + OFF_BTIN), 1024, 1024, (int)NINA, 0, rot, smem);
  tconv_big(p.w_in + (size_t)l * 1024 * 5400, 5400, (hf*)(ws + OFF_BTIN) + NINA * 1024, 1024, 1024, (int)NINB, 3, rot, smem);
  tconv_big(p.ffn_w_in + (size_t)l * 1024 * 5632, 5632, (hf*)(ws + OFF_BTFI), 1024, 1024, 5632, 2, rot, smem);
  tconv_big(p.w_out + (size_t)l * 1024 * 1024, 1024, (hf*)(ws + OFF_BTWO), 1024, 1024, 1024, 9, rot, smem);
  for (int k = 0; k < 3; ++k) tconv_big(p.w_branch + ((size_t)l * 3 + k) * 512 * 1024, 1024, (hf*)(ws + OFF_BTBR) + k * 512, 1536, 512, 1024, 9, rot, smem);
  tconv_big(p.w_glu + (size_t)l * 512 * 1024, 1024, (hf*)(ws + OFF_BTGLU), 512, 512, 1024, 1, rot, smem);
  for (int j = 0; j < 2; ++j) tconv_big(p.cmp_w1 + ((size_t)l * 2 + j) * 2048 * 256, 256, (hf*)(ws + OFF_BTC1) + (size_t)j * 256 * 2048, 2048, 2048, 256, 9, rot, smem);
  for (int j = 0; j < 2; ++j) tconv(p.cmp_w2 + ((size_t)l * 2 + j) * 256 * 64, 64, (hf*)(ws + OFF_BTC2) + (size_t)j * 64 * 256, 256, 256, 64, 9, rot, smem);
  for (int g = 0; g < 4; ++g) tconv(p.pool_w + ((size_t)l * 4 + g) * 128 * 128, 128, (hf*)(ws + OFF_BTPOOL) + (size_t)g * 128 * 128, 128, 128, 128, 9, rot, smem);

  const int gtid = obid() * 512 + otid(), gnt = gridDim.x * 512;
    const float* bre = p.b_re + (size_t)l * 32768; const float* bim = p.b_im + (size_t)l * 32768;
  const float* cre = p.c_re + (size_t)l * 32768; const float* cim = p.c_im + (size_t)l * 32768;
  hf* WC = (hf*)(ws + OFF_WC); hf* W1 = (hf*)(ws + OFF_W1); float* LAM16 = (float*)(ws + OFF_LAM16);
  const f2* E = (const f2*)(ws + OFF_ETAB) + (size_t)l * 2048 * 18;
  const float* DT = (const float*)(ws + OFF_CB1 + 2048) + l * 32;
  for (int idx = gtid; idx < 32 * 16 * 256; idx += gnt) {
    const int ci = idx & 15, co = (idx >> 4) & 15, d = (idx >> 8) & 15, g = idx >> 12;
    const float dt = DT[g];
    float sum = 0.f;
    for (int pp = 0; pp < 64; ++pp) {
      const f2 z = E[(g * 64 + pp) * 18 + 17], e = E[(g * 64 + pp) * 18 + d];
      const float br = bre[(g * 64 + pp) * 16 + ci], bi = bim[(g * 64 + pp) * 16 + ci];
      const float bbr = z[0] * br - z[1] * bi, bbi = z[0] * bi + z[1] * br;
      const float tr = e[0] * bbr - e[1] * bbi, ti = e[0] * bbi + e[1] * bbr;
      sum += cre[(g * 16 + co) * 64 + pp] * tr - cim[(g * 16 + co) * 64 + pp] * ti;
    }
    const hf v = (hf)(sum / dt);
    for (int t = d; t < 16; ++t) WC[((size_t)g * 256 + t * 16 + co) * 384 + (t - d) * 16 + ci] = v;
    if (d >= 1) for (int t = 0; t + d < 16; ++t) WC[((size_t)g * 256 + t * 16 + co) * 384 + (t + d) * 16 + ci] = (hf)0.f;
  }
  for (int idx = gtid; idx < 32 * 16 * 16 * 64; idx += gnt) {
    const int pp = idx & 63, co = (idx >> 6) & 15, t = (idx >> 10) & 15, g = idx >> 14;
    const f2 e = E[(g * 64 + pp) * 18 + t + 1];
    const float cr = cre[(g * 16 + co) * 64 + pp], cii = cim[(g * 16 + co) * 64 + pp];
    WC[((size_t)g * 256 + t * 16 + co) * 384 + 256 + pp] = (hf)(cr * e[0] - cii * e[1]);
    WC[((size_t)g * 256 + t * 16 + co) * 384 + 320 + pp] = (hf)(-(cr * e[1] + cii * e[0]));
  }
  for (int idx = gtid; idx < 32 * 64 * 256; idx += gnt) {
    const int ci = idx & 15, j = (idx >> 4) & 15, pp = (idx >> 8) & 63, g = idx >> 14;
    const float dt = DT[g];
    const f2 z = E[(g * 64 + pp) * 18 + 17], e = E[(g * 64 + pp) * 18 + 15 - j];
    const float br = bre[(g * 64 + pp) * 16 + ci], bi = bim[(g * 64 + pp) * 16 + ci];
    const float bbr = z[0] * br - z[1] * bi, bbi = z[0] * bi + z[1] * br;
    W1[((size_t)g * 128 + pp) * 256 + j * 16 + ci] = (hf)((e[0] * bbr - e[1] * bbi) / dt);
    W1[((size_t)g * 128 + 64 + pp) * 256 + j * 16 + ci] = (hf)((e[0] * bbi + e[1] * bbr) / dt);
  }
  for (int idx = gtid; idx < 2048; idx += gnt) { const f2 e = E[idx * 18 + 16]; LAM16[idx * 2] = e[0]; LAM16[idx * 2 + 1] = e[1]; }
  {
    float* red = (float*)(smem + 40960);
    float* CB1 = (float*)(ws + OFF_CB1);
    for (int job = obid(); job < 64; job += gridDim.x) {
      const int tj = otid(); const int j = job >> 5, cg8 = job & 31, c = tj & 7, kl = tj >> 3;
      const float* w1 = p.cmp_w1 + ((size_t)l * 2 + j) * 2048 * 256; const float* ps = p.cmp_pos + ((size_t)l * 2 + j) * 2048;
      float s = 0.f;
      for (int k = kl; k < 2048; k += 64) s += ps[k] * w1[(size_t)k * 256 + cg8 * 8 + c];
      __syncthreads();
      red[kl * 8 + c] = s;
      __syncthreads();
      if (tj < 8) { float tot = 0.f; for (int i = 0; i < 64; ++i) tot += red[i * 8 + tj]; CB1[j * 256 + cg8 * 8 + tj] = tot + p.cmp_b1[(l * 2 + j) * 256 + cg8 * 8 + tj]; }
    }
  }
}

DEVI void phase_0(const P& p) {
  const int gtid = obid() * 512 + otid(), gnt = gridDim.x * 512;
  f2* rope = (f2*)(p.ws + OFF_ROPE);
  for (int idx = gtid; idx < T_ * 32; idx += gnt) {
    const int i = idx & 31, t = idx >> 5;
    const double inv = exp(-(double)i * (9.210340371976184 / 32.0));
    const double ang = (double)p.pos[t] * inv;
    rope[idx] = (f2){(float)cos(ang), (float)sin(ang)};
  }
  f2* ET = (f2*)(p.ws + OFF_ETAB);
  for (int idx = gtid; idx < DEPTH_ * 2048 * 18; idx += gnt) {
    const int d = idx % 18, gp = idx / 18;
    const double dt = exp((double)p.log_dt[gp >> 6]);
    double re, im;
    if (d < 17) lampow(p.a_re[gp], p.a_im[gp], dt, d, re, im); else zohcoef(p.a_re[gp], p.a_im[gp], dt, re, im);
    ET[idx] = (f2){(float)re, (float)im};
  }
  if (gtid < DEPTH_ * 32) ((float*)(p.ws + OFF_CB1 + 2048))[gtid] = (float)exp((double)p.log_dt[gtid]);
  hf* XH = (hf*)(p.ws + OFF_XH);
  for (int idx = gtid; idx < T_ * 1024 / 4; idx += gnt) { const f4 v = ((const f4*)p.x)[idx]; *(h4*)(XH + (size_t)idx * 4) = pack4(v); }
}

DEVI void phase_ln(float* X, hf* XH, const float* __restrict__ g, const float* __restrict__ b) {
  const int tid_ = otid(), lane = tid_ & 63, gw = obid() * 8 + (tid_ >> 6), nw = gridDim.x * 8;
  for (int row = gw; row < T_; row += nw) {
    float* xr = X + (size_t)row * 1024;
    f4 v[4];
    float s = 0.f;
#pragma unroll
    for (int i = 0; i < 4; ++i) { v[i] = *(const f4*)(xr + i * 256 + lane * 4); s += (v[i][0] + v[i][1]) + (v[i][2] + v[i][3]); }
#pragma unroll
    for (int o = 32; o >= 1; o >>= 1) s += __shfl_xor(s, o);
    const float mu = s * (1.0f / 1024.0f);
    float q = 0.f;
#pragma unroll
    for (int i = 0; i < 4; ++i) { const f4 d = v[i] - mu; q += (d[0] * d[0] + d[1] * d[1]) + (d[2] * d[2] + d[3] * d[3]); }
#pragma unroll
    for (int o = 32; o >= 1; o >>= 1) q += __shfl_xor(q, o);
    const float rstd = rsqrtf(q * (1.0f / 1024.0f) + 1e-5f);
#pragma unroll
    for (int i = 0; i < 4; ++i) {
      const f4 gg = *(const f4*)(g + i * 256 + lane * 4), bb = *(const f4*)(b + i * 256 + lane * 4);
      const f4 y = (v[i] - mu) * rstd * gg + bb;
      *(f4*)(xr + i * 256 + lane * 4) = y;
      *(h4*)(XH + (size_t)row * 1024 + i * 256 + lane * 4) = pack4(y);
    }
  }
}

struct EpiIn {
  char* ws;
  DEVI void operator()(const f4 (&acc)[2][2][4][2], int brow, int bcol, int wr, int wc, int fr, int fq) const {
    const f2* rope = (const f2*)(ws + OFF_ROPE);
#pragma unroll
    for (int bj = 0; bj < 2; ++bj) {
      const int hc = (bcol >> 7) + bj;
      if (hc < 4) {
        hf* U = (hf*)(ws + OFF_USSM);
#pragma unroll
        for (int ai = 0; ai < 2; ++ai)
#pragma unroll
          for (int m = 0; m < 4; ++m) {
            __builtin_amdgcn_sched_barrier(0); const int t = brow + ai * 128 + wr * 64 + m * 16 + fr;
#pragma unroll
            for (int n = 0; n < 2; ++n) *(h4*)(U + ((size_t)(hc * 8 + wc * 2 + n) * 1024 + (t >> 4)) * 384 + (t & 15) * 16 + fq * 4) = pack4(acc[ai][bj][m][n]);
          }
      } else if (hc < 8) {
        hf* U = (hf*)(ws + OFF_UPOOL);
#pragma unroll
        for (int ai = 0; ai < 2; ++ai)
#pragma unroll
          for (int m = 0; m < 4; ++m) {
            __builtin_amdgcn_sched_barrier(0); const int t = brow + ai * 128 + wr * 64 + m * 16 + fr;
#pragma unroll
            for (int n = 0; n < 2; ++n) *(h4*)(U + (size_t)t * 512 + (hc - 4) * 128 + wc * 32 + n * 16 + fq * 4) = pack4(acc[ai][bj][m][n]);
          }
      } else if (hc < 18) {
        const bool isq = hc < 12;
        const int kvi = hc - 12;
        const bool dorope = isq || ((kvi & 1) == 0);
#pragma unroll
        for (int ai = 0; ai < 2; ++ai)
#pragma unroll
          for (int m = 0; m < 4; ++m) {
            __builtin_amdgcn_sched_barrier(0); const int t = brow + ai * 128 + wr * 64 + m * 16 + fr;
            hf* dst = isq ? (hf*)(ws + OFF_Q) + (size_t)t * 512 + ((hc - 8) * 2 + (wc >> 1)) * 64
                          : (hf*)(ws + OFF_KV + (size_t)kvi * SZ_KV1) + ((size_t)(wc >> 1) * T_ + t) * 64;
            const f4 v0 = acc[ai][bj][m][0], v1 = acc[ai][bj][m][1];
            if (dorope) {
              const int d1 = (wc & 1) * 16 + fq * 4;
              const f4 cs0 = *(const f4*)(rope + (size_t)t * 32 + d1), cs1 = *(const f4*)(rope + (size_t)t * 32 + d1 + 2);
              f4 o1, o2;
              o1[0] = v0[0] * cs0[0] - v1[0] * cs0[1]; o2[0] = v0[0] * cs0[1] + v1[0] * cs0[0];
              o1[1] = v0[1] * cs0[2] - v1[1] * cs0[3]; o2[1] = v0[1] * cs0[3] + v1[1] * cs0[2];
              o1[2] = v0[2] * cs1[0] - v1[2] * cs1[1]; o2[2] = v0[2] * cs1[1] + v1[2] * cs1[0];
              o1[3] = v0[3] * cs1[2] - v1[3] * cs1[3]; o2[3] = v0[3] * cs1[3] + v1[3] * cs1[2];
              *(h4*)(dst + d1) = pack4(o1); *(h4*)(dst + d1 + 32) = pack4(o2);
            } else {
              const int d = (wc & 1) * 32 + fq * 4;
              *(h4*)(dst + d) = pack4(v0); *(h4*)(dst + d + 16) = pack4(v1);
            }
          }
      } else if (hc == 18) {
        float* NG = (float*)(ws + OFF_NSAG);
        if (wc == 0) {
#pragma unroll
          for (int ai = 0; ai < 2; ++ai)
#pragma unroll
            for (int m = 0; m < 4; ++m) {
              __builtin_amdgcn_sched_barrier(0); const int t = brow + ai * 128 + wr * 64 + m * 16 + fr;
#pragma unroll
              for (int n = 0; n < 2; ++n) {
                const int c = n * 16 + fq * 4;
                if (c < 24) { f4 v = acc[ai][bj][m][n];
#pragma unroll
                  for (int j = 0; j < 4; ++j) v[j] = sigmoidf_(v[j]);
                  *(f4*)(NG + (size_t)t * 24 + c) = v; }
              }
            }
        }
      }
    }
  }
};

struct EpiGate {
  unsigned char* G;
  DEVI void operator()(const f4 (&acc)[2][2][4][2], int brow, int bcol, int wr, int wc, int fr, int fq) const {
#pragma unroll
    for (int ai = 0; ai < 2; ++ai)
#pragma unroll
      for (int m = 0; m < 4; ++m) {
        __builtin_amdgcn_sched_barrier(0);
        const int t = brow + ai * 128 + wr * 64 + m * 16 + fr;
#pragma unroll
        for (int bj = 0; bj < 2; ++bj)
#pragma unroll
          for (int n = 0; n < 2; ++n) {
            const f4 v = acc[ai][bj][m][n];
            unsigned w = 0u;
#pragma unroll
            for (int j = 0; j < 4; ++j) { const float gq = fminf(fmaxf(sigmoidf_(v[j]) * 255.0f + 0.5f, 1.0f), 255.0f); w |= ((unsigned)gq) << (8 * j); }
            *(unsigned*)(G + (size_t)t * 3072 + bcol + bj * 128 + wc * 32 + n * 16 + fq * 4) = w;
          }
      }
  }
};

struct EpiGlu {
  hf* Y;
  DEVI void operator()(const f4 (&acc)[2][2][4][2], int brow, int bcol, int wr, int wc, int fr, int fq) const {
#pragma unroll
    for (int ai = 0; ai < 2; ++ai)
#pragma unroll
      for (int m = 0; m < 4; ++m) {
        __builtin_amdgcn_sched_barrier(0); const int t = brow + ai * 128 + wr * 64 + m * 16 + fr;
#pragma unroll
        for (int n = 0; n < 2; ++n) {
          const f4 a = acc[ai][0][m][n], g = acc[ai][1][m][n]; f4 o;
#pragma unroll
          for (int j = 0; j < 4; ++j) o[j] = a[j] * sigmoidf_(g[j]);
          *(h4*)(Y + (size_t)t * 1536 + (bcol >> 1) + wc * 32 + n * 16 + fq * 4) = pack4(o);
        }
      }
  }
};

struct EpiSwiglu {
  hf* H;
  DEVI void operator()(const f4 (&acc)[2][2][4][2], int brow, int bcol, int wr, int wc, int fr, int fq) const {
#pragma unroll
    for (int ai = 0; ai < 2; ++ai)
#pragma unroll
      for (int m = 0; m < 4; ++m) {
        __builtin_amdgcn_sched_barrier(0); const int t = brow + ai * 128 + wr * 64 + m * 16 + fr;
#pragma unroll
        for (int n = 0; n < 2; ++n) {
          const f4 g = acc[ai][0][m][n], u = acc[ai][1][m][n]; f4 o;
#pragma unroll
          for (int j = 0; j < 4; ++j) o[j] = g[j] * sigmoidf_(g[j]) * u[j];
          *(h4*)(H + (size_t)t * FFH + (bcol >> 1) + wc * 32 + n * 16 + fq * 4) = pack4(o);
        }
      }
  }
};

struct HookMerge {
  const unsigned char* G;
  DEVI void operator()(f4 (&acc)[2][2][4][2], int t, int brow, int bcol, int wr, int wc, int fr, int fq) const {
    if (t != 8 && t != 16) return;
    const int k = (t >> 3) - 1;
    asm volatile("" : "+v"(fr), "+v"(fq));
#pragma unroll
    for (int ai = 0; ai < 2; ++ai) { __builtin_amdgcn_sched_barrier(0);
#pragma unroll
      for (int m = 0; m < 4; ++m) {
        const int row = brow + ai * 128 + wr * 64 + m * 16 + fr;
#pragma unroll
        for (int bj = 0; bj < 2; ++bj)
#pragma unroll
          for (int n = 0; n < 2; ++n) {
            const int col = bcol + bj * 128 + wc * 32 + n * 16 + fq * 4;
            const unsigned wa = *(const unsigned*)(G + (size_t)row * 3072 + k * 1024 + col), wb = *(const unsigned*)(G + (size_t)row * 3072 + (k + 1) * 1024 + col);
#pragma unroll
            for (int j = 0; j < 4; ++j) acc[ai][bj][m][n][j] *= (float)((wa >> (8 * j)) & 255u) * frcp((float)((wb >> (8 * j)) & 255u));
          }
      }
    }
  }
};
struct EpiMerge {
  const unsigned char* G; hf* M;
  DEVI void operator()(const f4 (&acc)[2][2][4][2], int brow, int bcol, int wr, int wc, int fr, int fq) const {
#pragma unroll
    for (int ai = 0; ai < 2; ++ai) { __builtin_amdgcn_sched_barrier(0);
#pragma unroll
      for (int m = 0; m < 4; ++m) {
        const int row = brow + ai * 128 + wr * 64 + m * 16 + fr;
#pragma unroll
        for (int bj = 0; bj < 2; ++bj)
#pragma unroll
          for (int n = 0; n < 2; ++n) {
            const int col = bcol + bj * 128 + wc * 32 + n * 16 + fq * 4;
            const unsigned w2 = *(const unsigned*)(G + (size_t)row * 3072 + 2048 + col);
            f4 o = acc[ai][bj][m][n];
#pragma unroll
            for (int j = 0; j < 4; ++j) o[j] *= (float)((w2 >> (8 * j)) & 255u) * (1.0f / 255.0f);
            *(h4*)(M + (size_t)row * 1024 + col) = pack4(o);
          }
      }
    }
  }
};
struct EpiRes {
  const float* resf; const hf* resh; float* X; hf* XH; const float* g; const float* b; unsigned long long* xbuf; unsigned* cnt; unsigned want; char* smem;
  DEVI void operator()(f4 (&acc)[2][2][4][2], int brow, int bcol, int wr, int wc, int fr, int fq) const {
    const int pm = brow >> 8, pn = bcol >> 8;
    const int tid = otid(), wid = __builtin_amdgcn_readfirstlane(tid >> 6), lane = tid & 63;
    f2* Pt = (f2*)smem;
    f2* S = (f2*)(smem + 8192);
#pragma unroll
    for (int ai = 0; ai < 2; ++ai) { __builtin_amdgcn_sched_barrier(0);
#pragma unroll
      for (int m = 0; m < 4; ++m) {
        const int row = brow + ai * 128 + wr * 64 + m * 16 + fr;
        float s1 = 0.f, s2 = 0.f;
#pragma unroll
        for (int bj = 0; bj < 2; ++bj)
#pragma unroll
          for (int n = 0; n < 2; ++n) {
            const size_t o = (size_t)row * 1024 + bcol + bj * 128 + wc * 32 + n * 16 + fq * 4;
            f4 rv;
            if (resf) rv = *(const f4*)(resf + o); else { const h4 rh = *(const h4*)(resh + o); rv = (f4){(float)rh[0], (float)rh[1], (float)rh[2], (float)rh[3]}; }
            const f4 y = rv * ALPHA + acc[ai][bj][m][n];
            acc[ai][bj][m][n] = y;
            s1 += (y[0] + y[1]) + (y[2] + y[3]); s2 += (y[0] * y[0] + y[1] * y[1]) + (y[2] * y[2] + y[3] * y[3]);
          }
        s1 += __shfl_xor(s1, 16); s1 += __shfl_xor(s1, 32); s2 += __shfl_xor(s2, 16); s2 += __shfl_xor(s2, 32);
        if (fq == 0) Pt[(ai * 128 + wr * 64 + m * 16 + fr) * 4 + wc] = (f2){s1, s2};
      }
    }
    __syncthreads();
    if (tid < 256) {
      const f2 a = Pt[tid * 4 + 0], b2 = Pt[tid * 4 + 1], c = Pt[tid * 4 + 2], d = Pt[tid * 4 + 3];
      const float sm = (a[0] + b2[0]) + (c[0] + d[0]), sq = (a[1] + b2[1]) + (c[1] + d[1]);
      __hip_atomic_store(xbuf + ((size_t)(pm * 256 + tid) * 4 + pn), ((unsigned long long)__float_as_uint(sq) << 32) | __float_as_uint(sm), __ATOMIC_RELAXED, __HIP_MEMORY_SCOPE_AGENT);
    }
    asm volatile("s_waitcnt vmcnt(0)" ::: "memory");
    if (wid < 4 && lane == 0) __hip_atomic_fetch_add(cnt + 64 * pm, 1u, __ATOMIC_RELAXED, __HIP_MEMORY_SCOPE_AGENT);
    if (wid == 0) {
      unsigned sp = 0;
      while ((unsigned)__builtin_amdgcn_readfirstlane(__hip_atomic_load(cnt + 64 * pm, __ATOMIC_RELAXED, __HIP_MEMORY_SCOPE_AGENT)) < want) { __builtin_amdgcn_s_sleep(2); if (++sp > (1u << 22)) break; }
      __builtin_amdgcn_fence(__ATOMIC_ACQUIRE, "agent");
    }
    asm volatile("s_waitcnt vmcnt(0) lgkmcnt(0)" ::: "memory");
    __syncthreads();
    if (tid < 256) {
      const unsigned long long* slot = xbuf + (size_t)(pm * 256 + tid) * 4;
      float sm = 0.f, sq = 0.f;
#pragma unroll
      for (int t = 0; t < 4; ++t) { const unsigned long long w = __hip_atomic_load(slot + t, __ATOMIC_RELAXED, __HIP_MEMORY_SCOPE_AGENT); sm += __uint_as_float((unsigned)w); sq += __uint_as_float((unsigned)(w >> 32)); }
      const float mu = sm * (1.0f / 1024.0f), var = sq * (1.0f / 1024.0f) - mu * mu;
      S[tid] = (f2){mu, rsqrtf(var + 1e-5f)};
    }
    __syncthreads();
    f4 gg[2][2], bb[2][2];
#pragma unroll
    for (int bj = 0; bj < 2; ++bj)
#pragma unroll
      for (int n = 0; n < 2; ++n) { const int col = bcol + bj * 128 + wc * 32 + n * 16 + fq * 4; gg[bj][n] = *(const f4*)(g + col); bb[bj][n] = *(const f4*)(b + col); }
#pragma unroll
    for (int ai = 0; ai < 2; ++ai) { __builtin_amdgcn_sched_barrier(0);
#pragma unroll
      for (int m = 0; m < 4; ++m) {
        const int rl = ai * 128 + wr * 64 + m * 16 + fr;
        const f2 st = S[rl];
#pragma unroll
        for (int bj = 0; bj < 2; ++bj)
#pragma unroll
          for (int n = 0; n < 2; ++n) {
            const size_t o = (size_t)(brow + rl) * 1024 + bcol + bj * 128 + wc * 32 + n * 16 + fq * 4;
            const f4 y = (acc[ai][bj][m][n] - st[0]) * st[1] * gg[bj][n] + bb[bj][n];
            if (X) *(f4*)(X + o) = y;
            if (XH) *(h4*)(XH + o) = pack4(y);
          }
      }
    }
  }
};


DEVI void ssm_c_tile(const P& p, int l, int g, int mt, int nt, char* smem) {
  char* ws = p.ws;
  const hf* A = (const hf*)(ws + OFF_USSM) + ((size_t)g * 1024 + mt * 128) * 384;
  const hf* Bt = (const hf*)(ws + OFF_WC) + ((size_t)g * 256 + nt * 64) * 384;
  const float dt = ((const float*)(ws + OFF_CB1 + 2048))[l * 32 + g];
  const float* Dk = p.ssm_d + l * 512 + g * 16;
  hf* Y = (hf*)(ws + OFF_YGELU);
  auto af = [&](int r, int k) { return A + (size_t)r * 384 + k; };
  auto bf = [&](int n, int k) { return Bt + (size_t)n * 384 + k; };
  auto ef = [&](int r, int c0, f4 v) {
    const int R = mt * 128 + r, n = nt * 64 + c0, li = n >> 4, co = n & 15;
    const h4 u = *(const h4*)(A + (size_t)r * 384 + n);
    const f4 dd = *(const f4*)(Dk + co); f4 o;
#pragma unroll
    for (int jj = 0; jj < 4; ++jj) o[jj] = gelu_tanh(dt * v[jj] + dd[jj] * (float)u[jj]);
    *(h4*)(Y + ((size_t)R * 16 + li) * 512 + g * 16 + co) = pack4(o);
  };
  sgemm_tile<2>(384, af, bf, ef, smem);
}

DEVI void ssm_ab(const P& p, int l, int g, int b, char* smem) {
  char* ws = p.ws;
  float* SPL = (float*)(smem + 65536);
  const hf* A = (const hf*)(ws + OFF_USSM) + ((size_t)g * 1024 + b * 128) * 384;
  for (int nt = 0; nt < 2; ++nt) {
    const hf* Bt = (const hf*)(ws + OFF_W1) + ((size_t)g * 128 + nt * 64) * 256;
    auto af = [&](int r, int k) { return A + (size_t)r * 384 + k; };
    auto bf = [&](int n, int k) { return Bt + (size_t)n * 256 + k; };
    auto ef = [&](int r, int c0, f4 v) { *(f4*)(SPL + r * 128 + nt * 64 + c0) = v; };
    sgemm_tile<2>(256, af, bf, ef, smem);
  }
  __syncthreads();
  {
    const int tid = otid(), pp = tid & 63, seg = __builtin_amdgcn_readfirstlane(tid >> 6), c0 = seg * 16;
    const f2 lam = *(const f2*)((const float*)(ws + OFF_LAM16) + (g * 64 + pp) * 2);
    float lr[16], li[16];
    float hr = 0.f, hi = 0.f;
#pragma unroll
    for (int i = 0; i < 16; ++i) {
      lr[i] = hr; li[i] = hi;
      const float sr = SPL[(c0 + i) * 128 + pp], si = SPL[(c0 + i) * 128 + 64 + pp];
      const float nr = lam[0] * hr - lam[1] * hi + sr, ni = lam[0] * hi + lam[1] * hr + si;
      hr = nr; hi = ni;
    }
    f2* E = (f2*)smem;
    E[seg * 64 + pp] = (f2){hr, hi};
    float qr = lam[0], qi = lam[1];
#pragma unroll
    for (int s = 0; s < 4; ++s) { const float tr = qr * qr - qi * qi, ti = 2.f * qr * qi; qr = tr; qi = ti; }
    __syncthreads();
    float Hr = 0.f, Hi = 0.f;
    for (int s = 0; s < seg; ++s) { const f2 e = E[s * 64 + pp]; const float tr = qr * Hr - qi * Hi + e[0], ti = qr * Hi + qi * Hr + e[1]; Hr = tr; Hi = ti; }
    hf* U = (hf*)(ws + OFF_USSM) + ((size_t)g * 1024 + b * 128 + c0) * 384;
    float pr = 1.f, pi = 0.f;
#pragma unroll
    for (int i = 0; i < 16; ++i) {
      const float outr = lr[i] + pr * Hr - pi * Hi, outi = li[i] + pr * Hi + pi * Hr;
      U[(size_t)i * 384 + 256 + pp] = (hf)outr; U[(size_t)i * 384 + 320 + pp] = (hf)outi;
      const float tr = pr * lam[0] - pi * lam[1], ti = pr * lam[1] + pi * lam[0]; pr = tr; pi = ti;
    }
  }
  __syncthreads();
}

DEVI void phase_2(const P& p, int l, char* smem) {
  char* ws = p.ws;
  const int G = gridDim.x;
  for (int it = obid(); it < 256; it += G) {
    const int nt = it & 3, mt = (it >> 2) & 15, jh = it >> 6, j = jh >> 1, h = jh & 1;
    const hf* src = (const hf*)(ws + OFF_KV + (size_t)j * SZ_KV1) + (size_t)h * T_ * 64;
    const hf* Bt = (const hf*)(ws + OFF_BTC1) + ((size_t)j * 256 + nt * 64) * 2048;
    const float* cb = (const float*)(ws + OFF_CB1) + j * 256 + nt * 64;
    hf* HG = (hf*)(ws + OFF_HG) + ((size_t)jh * 1024 + mt * 64) * 256 + nt * 64;
    auto af = [&](int r, int k) { const int R = mt * 64 + r, b = R >> 7, n = min(R & 127, 126); return src + ((size_t)b * 2048 + 16 * n) * 64 + k; };
    auto bf = [&](int n, int k) { return Bt + (size_t)n * 2048 + k; };
    auto ef = [&](int r, int c0, f4 v) { const f4 bb = *(const f4*)(cb + c0); f4 o;
#pragma unroll
      for (int jj = 0; jj < 4; ++jj) o[jj] = gelu_tanh(v[jj] + bb[jj]);
      *(h4*)(HG + (size_t)r * 256 + c0) = pack4(o); };
    sgemm_tile<1>(2048, af, bf, ef, smem);
  }
  for (int it = obid(); it < 256; it += G) ssm_ab(p, l, it >> 3, it & 7, smem);
  {
    const hf* U = (const hf*)(ws + OFF_UPOOL); hf* PO = (hf*)(ws + OFF_POOLED);
    const int gtid = obid() * 512 + otid(), gnt = G * 512;
    for (int idx = gtid; idx < T_ * 64; idx += gnt) {
      const int c8 = idx & 63, t = idx >> 6, s = t & (S_ - 1), gi = c8 >> 4, w = 2 << gi;
      const int cnt = min(w, s + 1);
      float sum[8];
#pragma unroll
      for (int i = 0; i < 8; ++i) sum[i] = 0.f;
      for (int q = 0; q < cnt; ++q) { const h8 v = *(const h8*)(U + (size_t)(t - q) * 512 + c8 * 8);
#pragma unroll
        for (int i = 0; i < 8; ++i) sum[i] += (float)v[i]; }
      const h8 cur = *(const h8*)(U + (size_t)t * 512 + c8 * 8);
      const float inv = 1.0f / (float)cnt;
      h8 o;
#pragma unroll
      for (int i = 0; i < 8; ++i) o[i] = (hf)(sum[i] * inv - (float)cur[i]);
      *(h8*)(PO + (size_t)t * 512 + c8 * 8) = o;
    }
  }
}

DEVI void phase_3(const P& p, int l, char* smem) {
  char* ws = p.ws;
  const int G = gridDim.x;
  for (int it = obid(); it < 1024; it += G) ssm_c_tile(p, l, it >> 5, (it >> 2) & 7, it & 3, smem);
  for (int it = G - 1 - obid(); it < 32; it += G) {
    const int mt = it & 7, jh = it >> 3, j = jh >> 1, h = jh & 1;
    const hf* A = (const hf*)(ws + OFF_HG) + ((size_t)jh * 1024 + mt * 128) * 256;
    const hf* Bt = (const hf*)(ws + OFF_BTC2) + (size_t)j * 64 * 256;
    hf* KC = (hf*)(ws + OFF_KCOMP);
    auto af = [&](int r, int k) { return A + (size_t)r * 256 + k; };
    auto bf = [&](int n, int k) { return Bt + (size_t)n * 256 + k; };
    auto ef = [&](int r, int c0, f4 v) { const int R = mt * 128 + r, b = R >> 7, n = R & 127; *(h4*)(KC + ((((size_t)j * 8 + b) * 2 + h) * 128 + n) * 64 + c0) = pack4(v); };
    sgemm_tile<2>(256, af, bf, ef, smem);
  }
  for (int it = obid(); it < 1024; it += G) {
    const int nt = it & 1, gi = (it >> 1) & 3, mt = it >> 3;
    const hf* A = (const hf*)(ws + OFF_POOLED) + (size_t)mt * 128 * 512 + gi * 128;
    const hf* Bt = (const hf*)(ws + OFF_BTPOOL) + ((size_t)gi * 128 + nt * 64) * 128;
    const float* sc = p.pool_scale + l * 512 + gi * 128 + nt * 64;
    hf* Y = (hf*)(ws + OFF_YBR) + (size_t)mt * 128 * 1536 + 512 + gi * 128 + nt * 64;
    auto af = [&](int r, int k) { return A + (size_t)r * 512 + k; };
    auto bf = [&](int n, int k) { return Bt + (size_t)n * 128 + k; };
    auto ef = [&](int r, int c0, f4 v) { const f4 s4 = *(const f4*)(sc + c0); *(h4*)(Y + (size_t)r * 1536 + c0) = pack4(v * s4); };
    sgemm_tile<2>(128, af, bf, ef, smem);
  }
}


DEVI int crow16(int i, int hh) { return (i & 3) + 8 * (i >> 2) + 4 * hh; }
constexpr float LOG2E = 1.4426950408889634f;

struct NsaCtx {
  hf* Kb; hf* Vb; int tid, w, lane, l32, hh;
  h8 qf[4];
};
DEVI void nsa_stage_load(const NsaCtx& c, const hf* kt, const hf* vt, h8& kr, h8& vr) {
  kr = *(const h8*)(kt + (c.tid >> 3) * 64 + (c.tid & 7) * 8);
  vr = *(const h8*)(vt + c.lane * 64 + c.w * 8);
}
DEVI void nsa_stage_store(const NsaCtx& c, int buf, const h8& kr, const h8& vr) {
  *(h8*)(c.Kb + buf * 4608 + (c.tid >> 3) * 72 + (c.tid & 7) * 8) = kr;
#pragma unroll
  for (int i = 0; i < 8; ++i) c.Vb[buf * 4608 + (c.w * 8 + i) * 72 + c.lane] = vr[i];
}
DEVI void nsa_compute_s(const NsaCtx& c, int buf, f16v (&s)[2]) {
#pragma unroll
  for (int kt = 0; kt < 2; ++kt) {
#pragma unroll
    for (int i = 0; i < 16; ++i) s[kt][i] = 0.f;
#pragma unroll
    for (int st = 0; st < 4; ++st) {
      const h8 a = *(const h8*)(c.Kb + buf * 4608 + (kt * 32 + c.l32) * 72 + st * 16 + c.hh * 8);
      s[kt] = __builtin_amdgcn_mfma_f32_32x32x16_f16(a, c.qf[st], s[kt], 0, 0, 0);
    }
  }
}
DEVI void nsa_compute_pv(const NsaCtx& c, int buf, const f16v (&pr)[2], f16v (&o)[2]) {
#pragma unroll
  for (int kt = 0; kt < 2; ++kt)
#pragma unroll
    for (int s2 = 0; s2 < 2; ++s2) {
      h8 pb;
#pragma unroll
      for (int j = 0; j < 8; ++j) pb[j] = (hf)pr[kt][8 * s2 + j];
#pragma unroll
      for (int dt = 0; dt < 2; ++dt) {
        const hf* vrow = c.Vb + buf * 4608 + (dt * 32 + c.l32) * 72 + kt * 32 + s2 * 16 + c.hh * 4;
        const h4 lo = *(const h4*)vrow, hi = *(const h4*)(vrow + 8);
        h8 a; a[0] = lo[0]; a[1] = lo[1]; a[2] = lo[2]; a[3] = lo[3]; a[4] = hi[0]; a[5] = hi[1]; a[6] = hi[2]; a[7] = hi[3];
        o[dt] = __builtin_amdgcn_mfma_f32_32x32x16_f16(a, pb, o[dt], 0, 0, 0);
      }
    }
}

template <int MODE>
DEVI void nsa_run(const NsaCtx& c, unsigned tiles, const hf* Kbase, const hf* Vbase, int t, int qb, unsigned selmask, f16v (&o)[2], float& m, float& l) {
  h8 kr, vr;
  int j = __builtin_ctz(tiles); tiles &= tiles - 1;
  nsa_stage_load(c, Kbase + (size_t)j * 4096, Vbase + (size_t)j * 4096, kr, vr);
  __syncthreads();
  nsa_stage_store(c, 0, kr, vr);
  __syncthreads();
  int buf = 0;
  while (true) {
    const bool more = tiles != 0u;
    int jn = 0;
    if (more) { jn = __builtin_ctz(tiles); tiles &= tiles - 1; nsa_stage_load(c, Kbase + (size_t)jn * 4096, Vbase + (size_t)jn * 4096, kr, vr); }
    bool tile_ok = true;
    if (MODE == 1) tile_ok = (selmask >> j) & 1u;
    if (MODE != 1 || __builtin_amdgcn_ballot_w64(tile_ok) != 0ull) {
    f16v s[2];
    nsa_compute_s(c, buf, s);
    const bool edge = (j == qb) || (MODE == 2 && j == qb - 8);
    float mx = -1e30f;
    if (edge) {
#pragma unroll
      for (int kt = 0; kt < 2; ++kt)
#pragma unroll
        for (int i = 0; i < 16; ++i) {
          const int key = j * 64 + kt * 32 + crow16(i, c.hh);
          bool ok = tile_ok && key <= t;
          if (MODE == 2) ok = ok && (t - key < 512);
          const float v = ok ? s[kt][i] : -1e30f;
          s[kt][i] = v; mx = fmaxf(mx, v);
        }
    } else {
#pragma unroll
      for (int kt = 0; kt < 2; ++kt)
#pragma unroll
        for (int i = 0; i < 16; ++i) {
          const float v = (MODE == 2 || tile_ok) ? s[kt][i] : -1e30f;
          s[kt][i] = v; mx = fmaxf(mx, v);
        }
    }
    mx = fmaxf(mx, __shfl_xor(mx, 32));
    const float mn = fmaxf(m, mx), corr = __builtin_amdgcn_exp2f(m - mn);
    m = mn;
    float ls = 0.f;
    if (!edge && (MODE == 2 || j > 0)) {
#pragma unroll
      for (int kt = 0; kt < 2; ++kt)
#pragma unroll
        for (int i = 0; i < 16; ++i) { const float pv = __builtin_amdgcn_exp2f(s[kt][i] - mn); s[kt][i] = pv; ls += pv; }
    } else {
#pragma unroll
      for (int kt = 0; kt < 2; ++kt)
#pragma unroll
        for (int i = 0; i < 16; ++i) { const float pv = s[kt][i] > -1e29f ? __builtin_amdgcn_exp2f(s[kt][i] - mn) : 0.f; s[kt][i] = pv; ls += pv; }
    }
    l = l * corr + ls;
    if (__builtin_amdgcn_ballot_w64(corr != 1.0f) != 0ull) {
#pragma unroll
      for (int dt = 0; dt < 2; ++dt)
#pragma unroll
        for (int i = 0; i < 16; ++i) o[dt][i] *= corr;
    }
    nsa_compute_pv(c, buf, s, o);
    }
    if (more) nsa_stage_store(c, buf ^ 1, kr, vr);
    __syncthreads();
    if (!more) break;
    buf ^= 1; j = jn;
  }
}

DEVI void nsa_item(const P& p, int b, int hkv, int qb, char* smem) {
  char* ws = p.ws;
  NsaCtx c;
  c.Kb = (hf*)smem; c.Vb = (hf*)(smem + 2 * 9216);
  unsigned* maskw = (unsigned*)(smem + 36864);
  float* score = (float*)(smem + 36864 + 256);
  float* impP = (float*)(smem + 36864 + 256 + 8448);
  c.tid = otid(); c.w = __builtin_amdgcn_readfirstlane(c.tid >> 6); c.lane = c.tid & 63; c.l32 = c.lane & 31; c.hh = c.lane >> 5;
  const int g = c.w >> 1, half = c.w & 1, tl = half * 32 + c.l32, t = qb * 64 + tl, tg = b * S_ + t, head = hkv * 4 + g;
  {
    const hf* Qp = (const hf*)(ws + OFF_Q) + (size_t)tg * 512 + head * 64 + c.hh * 8;
#pragma unroll
    for (int st = 0; st < 4; ++st) { h8 q = *(const h8*)(Qp + st * 16);
#pragma unroll
      for (int i = 0; i < 8; ++i) q[i] = (hf)((float)q[i] * (0.125f * LOG2E));
      c.qf[st] = q; }
  }
  const float* NG = (const float*)(ws + OFF_NSAG) + (size_t)tg * 24;
  const float g_cmp = NG[head], g_sel = NG[8 + head], g_win = NG[16 + head];
  f16v fin[2];
  {
    const hf* Kc = (const hf*)(ws + OFF_KCOMP) + (((size_t)0 * 8 + b) * 2 + hkv) * 128 * 64;
    const hf* Vc = (const hf*)(ws + OFF_KCOMP) + (((size_t)1 * 8 + b) * 2 + hkv) * 128 * 64;
    h8 kr, vr, kr1, vr1;
    nsa_stage_load(c, Kc, Vc, kr, vr); nsa_stage_load(c, Kc + 4096, Vc + 4096, kr1, vr1);
    __syncthreads();
    nsa_stage_store(c, 0, kr, vr); nsa_stage_store(c, 1, kr1, vr1);
    __syncthreads();
    f16v s0[2], s1[2];
    nsa_compute_s(c, 0, s0); nsa_compute_s(c, 1, s1);
    float mx = -1e30f;
#pragma unroll
    for (int kt = 0; kt < 2; ++kt)
#pragma unroll
      for (int i = 0; i < 16; ++i) {
        const int n0 = kt * 32 + crow16(i, c.hh), n1 = 64 + n0;
        const float v0 = (16 * n0 + 31 <= t) ? s0[kt][i] : -1e30f, v1 = (16 * n1 + 31 <= t) ? s1[kt][i] : -1e30f;
        s0[kt][i] = v0; s1[kt][i] = v1; mx = fmaxf(mx, fmaxf(v0, v1));
      }
    mx = fmaxf(mx, __shfl_xor(mx, 32));
    float ls = 0.f;
#pragma unroll
    for (int kt = 0; kt < 2; ++kt)
#pragma unroll
      for (int i = 0; i < 16; ++i) {
        const float p0 = s0[kt][i] > -1e29f ? __builtin_amdgcn_exp2f(s0[kt][i] - mx) : 0.f, p1 = s1[kt][i] > -1e29f ? __builtin_amdgcn_exp2f(s1[kt][i] - mx) : 0.f;
        s0[kt][i] = p0; s1[kt][i] = p1; ls += p0 + p1;
      }
    ls += __shfl_xor(ls, 32);
    const float inv = ls > 0.f ? 1.0f / ls : 0.f;
#pragma unroll
    for (int kt = 0; kt < 2; ++kt)
#pragma unroll
      for (int i = 0; i < 16; ++i) { s0[kt][i] *= inv; s1[kt][i] *= inv; }
    float* ip = impP + (g * 64 + tl) * 33;
#pragma unroll
    for (int kt = 0; kt < 2; ++kt)
#pragma unroll
      for (int q = 0; q < 4; ++q) {
        const int j0 = kt * 8 + q * 2 + c.hh;
        ip[j0] = s0[kt][4 * q] + s0[kt][4 * q + 1] + s0[kt][4 * q + 2] + 0.5f * s0[kt][4 * q + 3];
        ip[16 + j0] = s1[kt][4 * q] + s1[kt][4 * q + 1] + s1[kt][4 * q + 2] + 0.5f * s1[kt][4 * q + 3];
      }
    __syncthreads();
#pragma unroll
    for (int kt = 0; kt < 2; ++kt)
#pragma unroll
      for (int q = 0; q < 4; ++q) {
        const int j0 = kt * 8 + q * 2 + c.hh;
        ip[j0 + 1] += 0.5f * s0[kt][4 * q + 3];
        if (16 + j0 + 1 < 32) ip[16 + j0 + 1] += 0.5f * s1[kt][4 * q + 3];
      }
#pragma unroll
    for (int dt = 0; dt < 2; ++dt)
#pragma unroll
      for (int i = 0; i < 16; ++i) fin[dt][i] = 0.f;
    nsa_compute_pv(c, 0, s0, fin); nsa_compute_pv(c, 1, s1, fin);
#pragma unroll
    for (int dt = 0; dt < 2; ++dt)
#pragma unroll
      for (int i = 0; i < 16; ++i) fin[dt][i] *= g_cmp;
    __syncthreads();
  }
  for (int idx = c.tid; idx < 2048; idx += 512) {
    const int tok = idx >> 5, j = idx & 31;
    const float imp = ((impP[(0 * 64 + tok) * 33 + j] + impP[(1 * 64 + tok) * 33 + j]) + impP[(2 * 64 + tok) * 33 + j]) + impP[(3 * 64 + tok) * 33 + j];
    const bool forced = (j == 0) || (j == qb) || (j == qb - 1);
    score[tok * 33 + j] = forced ? 1e30f : (j <= qb ? imp : -1e30f);
  }
  if (c.tid < 64) maskw[c.tid] = 0u;
  __syncthreads();
  for (int idx = c.tid; idx < 2048; idx += 512) {
    const int tok = idx >> 5, j = idx & 31;
    const float sj = score[tok * 33 + j];
    int rank = 0;
    for (int jj = 0; jj < 32; ++jj) { const float o = score[tok * 33 + jj]; rank += (o > sj || (o == sj && jj < j)) ? 1 : 0; }
    if (rank < 16 && sj > -1e29f) atomicOr(&maskw[tok], 1u << j);
  }
  __syncthreads();
  const unsigned selmask = maskw[tl];
  unsigned anym = 0u;
  for (int i = 0; i < 64; ++i) anym |= maskw[i];
  {
    f16v o[2];
#pragma unroll
    for (int dt = 0; dt < 2; ++dt)
#pragma unroll
      for (int i = 0; i < 16; ++i) o[dt][i] = 0.f;
    float m = -1e30f, l = 0.f;
    const hf* Kb = (const hf*)(ws + OFF_KV + 2 * SZ_KV1) + ((size_t)hkv * T_ + (size_t)b * S_) * 64;
    const hf* Vb = (const hf*)(ws + OFF_KV + 3 * SZ_KV1) + ((size_t)hkv * T_ + (size_t)b * S_) * 64;
    nsa_run<1>(c, anym, Kb, Vb, t, qb, selmask, o, m, l);
    l += __shfl_xor(l, 32);
    const float sc = l > 0.f ? g_sel / l : 0.f;
#pragma unroll
    for (int dt = 0; dt < 2; ++dt)
#pragma unroll
      for (int i = 0; i < 16; ++i) fin[dt][i] += o[dt][i] * sc;
  }
  {
    f16v o[2];
#pragma unroll
    for (int dt = 0; dt < 2; ++dt)
#pragma unroll
      for (int i = 0; i < 16; ++i) o[dt][i] = 0.f;
    float m = -1e30f, l = 0.f;
    const hf* Kb = (const hf*)(ws + OFF_KV + 4 * SZ_KV1) + ((size_t)hkv * T_ + (size_t)b * S_) * 64;
    const hf* Vb = (const hf*)(ws + OFF_KV + 5 * SZ_KV1) + ((size_t)hkv * T_ + (size_t)b * S_) * 64;
    const int jlo = max(qb - 8, 0);
    const unsigned tiles = (unsigned)((((unsigned long long)2 << qb) - 1ull) & ~((1ull << jlo) - 1ull));
    nsa_run<2>(c, tiles, Kb, Vb, t, qb, 0u, o, m, l);
    l += __shfl_xor(l, 32);
    const float sc = l > 0.f ? g_win / l : 0.f;
#pragma unroll
    for (int dt = 0; dt < 2; ++dt)
#pragma unroll
      for (int i = 0; i < 16; ++i) fin[dt][i] += o[dt][i] * sc;
  }
  hf* Y = (hf*)(ws + OFF_YBR) + (size_t)tg * 1536 + 1024 + head * 64;
#pragma unroll
  for (int dt = 0; dt < 2; ++dt)
#pragma unroll
    for (int q = 0; q < 4; ++q) {
      h4 ov; ov[0] = (hf)fin[dt][4 * q]; ov[1] = (hf)fin[dt][4 * q + 1]; ov[2] = (hf)fin[dt][4 * q + 2]; ov[3] = (hf)fin[dt][4 * q + 3];
      *(h4*)(Y + dt * 32 + q * 8 + c.hh * 4) = ov;
    }
}

DEVI void phase_4(const P& p, int l, char* smem) {
  for (int pi = obid(); pi < 256; pi += gridDim.x) {
    const int b = pi >> 5, hkv = (pi >> 4) & 1, x = pi & 15;
#pragma unroll 1
    for (int k = 0; k < 2; ++k) nsa_item(p, b, hkv, k ? x : 31 - x, smem);
  }
}

#ifndef REPW
#define REPW 1
#endif
#ifndef REP1
#define REP1 1
#endif
#ifndef REP2
#define REP2 1
#endif
#ifndef REP3
#define REP3 1
#endif
#ifndef REP4
#define REP4 1
#endif
#ifndef REP5
#define REP5 1
#endif
#ifndef REP6
#define REP6 1
#endif
#ifndef REP9
#define REP9 1
#endif
#ifndef XSYNC
#define XSYNC 0
#endif
DEVI const P& getp() {
  const __attribute__((address_space(4))) char* k = (const __attribute__((address_space(4))) char*)__builtin_amdgcn_kernarg_segment_ptr();
  asm volatile("" : "+s"(k));
  return *(const P*)k;
}
__global__ void __launch_bounds__(512) mega(P p_unused) {
  cg::grid_group grid = cg::this_grid();
  __shared__ __attribute__((aligned(16))) char smem[131072];
  __shared__ uint4 xb_words;
  if (threadIdx.x == 0) xb_words = make_uint4(0u, 0u, 0u, 0u);
  __syncthreads();
  (void)xcd_barrier_post((unsigned*)(getp().ws + OFF_BAR), (volatile LAS unsigned*)&xb_words);
#define GSYNC() do { XcdBarrier xb_; xb_.bar = (unsigned*)(getp().ws + OFF_BAR); xb_.x = xb_xcc_id(); xb_.st = (volatile LAS unsigned*)&xb_words; xcd_barrier(xb_); } while (0)
  phase_0(getp());
  grid.sync();
  for (int r = 0; r < XSYNC; ++r) GSYNC();
#pragma unroll 1
  for (int ll = 0; ll < DEPTH_; ++ll) {
    int l = ll; asm volatile("" : "+s"(l));
    if (l == 0) { phase_w(getp(), 0, smem); GSYNC(); }
    { const P& p = getp(); EpiIn e{p.ws}; for (int r = 0; r < REP1; ++r) { gemm256((const hf*)(p.ws + OFF_XH), 1024, (const hf*)(p.ws + OFF_BTIN), 1024, 1024, 64, 10, smem, e, NoHook()); GSYNC(); } }
    phase_2(getp(), l, smem);
    w_ffo(getp(), l, smem);
    GSYNC();
    for (int r = 0; r < REP3; ++r) { phase_3(getp(), l, smem); GSYNC(); }
    phase_4(getp(), l, smem);
    { const P& p = getp(); EpiGlu e{(hf*)(p.ws + OFF_YBR)}; gemm256((const hf*)(p.ws + OFF_YGELU), 512, (const hf*)(p.ws + OFF_BTGLU), 512, 512, 64, 4, smem, e, NoHook()); }
    { const P& p = getp(); EpiGate e{(unsigned char*)(p.ws + OFF_BRG)}; gemm256((const hf*)(p.ws + OFF_XH), 1024, (const hf*)(p.ws + OFF_BTIN) + NINA * 1024, 1024, 1024, 64, 12, smem, e, NoHook()); }
    GSYNC();
    { const P& p = getp(); HookMerge h{(const unsigned char*)(p.ws + OFF_BRG)}; EpiMerge e{(const unsigned char*)(p.ws + OFF_BRG), (hf*)(p.ws + OFF_MERGED)};
      for (int r = 0; r < REP6; ++r) { gemm256((const hf*)(p.ws + OFF_YBR), 1536, (const hf*)(p.ws + OFF_BTBR), 1536, 1536, 64, 4, smem, e, h); GSYNC(); } }
    { const P& p = getp(); EpiRes e{nullptr, (const hf*)(p.ws + OFF_XH), nullptr, (hf*)(p.ws + OFF_XH), p.ln_g + (l * 2 + 0) * 1024, p.ln_b + (l * 2 + 0) * 1024,
                                   (unsigned long long*)(p.ws + OFF_XS), (unsigned*)(p.ws + OFF_BAR + 16384), 16u * (unsigned)(2 * l + 1), smem};
      gemm256((const hf*)(p.ws + OFF_MERGED), 1024, (const hf*)(p.ws + OFF_BTWO), 1024, 1024, 64, 4, smem, e, NoHook()); }
    GSYNC();
    { const P& p = getp(); EpiSwiglu e{(hf*)(p.ws + OFF_HFF)}; for (int r = 0; r < REP9; ++r) { gemm256((const hf*)(p.ws + OFF_XH), 1024, (const hf*)(p.ws + OFF_BTFI), 1024, 1024, 64, 22, smem, e, NoHook()); GSYNC(); } }
    { const P& p = getp(); EpiRes e{nullptr, (const hf*)(p.ws + OFF_XH), l == DEPTH_ - 1 ? p.out : nullptr, l == DEPTH_ - 1 ? nullptr : (hf*)(p.ws + OFF_XH), p.ln_g + (l * 2 + 1) * 1024, p.ln_b + (l * 2 + 1) * 1024,
                                   (unsigned long long*)(p.ws + OFF_XS), (unsigned*)(p.ws + OFF_BAR + 16384), 16u * (unsigned)(2 * l + 2), smem};
      gemm256((const hf*)(p.ws + OFF_HFF), FFH, (const hf*)(p.ws + OFF_BTFO), FFH, FFH, 64, 4, smem, e, NoHook()); }
    if (l + 1 < DEPTH_) phase_w(getp(), l + 1, smem);
    GSYNC();
  }
}

extern "C" void kernel_launch(void* const* d_in, const int* in_sizes, int n_in, void* d_out, int out_size, void* d_ws, size_t ws_size, hipStream_t stream) {
  static int grid_blocks = 0;
  if (!grid_blocks) {
    int dev = 0, cus = 0, per = 0;
    hipGetDevice(&dev);
    hipDeviceGetAttribute(&cus, hipDeviceAttributeMultiprocessorCount, dev);
    hipOccupancyMaxActiveBlocksPerMultiprocessor(&per, mega, 512, 0);
    if (per < 1) per = 1;
    if (per > 1) per = 1;
    grid_blocks = cus * per;
  }
  P p{};
  p.x = (const float*)d_in[0]; p.pos = (const int*)d_in[1]; p.w_in = (const float*)d_in[2]; p.a_re = (const float*)d_in[3]; p.a_im = (const float*)d_in[4];
  p.log_dt = (const float*)d_in[5]; p.b_re = (const float*)d_in[6]; p.b_im = (const float*)d_in[7]; p.c_re = (const float*)d_in[8]; p.c_im = (const float*)d_in[9];
  p.ssm_d = (const float*)d_in[10]; p.w_glu = (const float*)d_in[11]; p.pool_w = (const float*)d_in[12]; p.pool_scale = (const float*)d_in[13];
  p.cmp_pos = (const float*)d_in[14]; p.cmp_w1 = (const float*)d_in[15]; p.cmp_b1 = (const float*)d_in[16]; p.cmp_w2 = (const float*)d_in[17];
  p.w_branch = (const float*)d_in[18]; p.w_out = (const float*)d_in[19]; p.ln_g = (const float*)d_in[20]; p.ln_b = (const float*)d_in[21];
  p.ffn_w_in = (const float*)d_in[22]; p.ffn_w_out = (const float*)d_in[23];
  p.out = (float*)d_out; p.ws = (char*)d_ws;
  hipMemsetAsync((char*)d_ws + OFF_BAR, 0, 32768, stream);
  void* args[] = {&p};
  hipError_t e = hipLaunchCooperativeKernel((void*)mega, dim3(grid_blocks), dim3(512), args, 0, stream);
  if (e != hipSuccess) fprintf(stderr, "cooperative launch failed: %s (grid %d)\n", hipGetErrorString(e), grid_blocks);
}
```

```cpp
#include <hip/hip_runtime.h>
#include <hip/hip_cooperative_groups.h>
#include <cstdio>
namespace cg = cooperative_groups;

typedef _Float16 hf;
typedef _Float16 h8 __attribute__((ext_vector_type(8)));
typedef _Float16 h4 __attribute__((ext_vector_type(4)));
typedef float f4 __attribute__((ext_vector_type(4)));
typedef float f2 __attribute__((ext_vector_type(2)));
typedef float f16v __attribute__((ext_vector_type(16)));
#define DEVI __device__ __forceinline__
DEVI int otid() { int t = threadIdx.x; asm volatile("" : "+v"(t)); return t; }
DEVI int obid() { int b = blockIdx.x; asm volatile("" : "+s"(b)); return b; }

constexpr int T_ = 16384, S_ = 2048, DEPTH_ = 4;
constexpr int NIN = 5632;
constexpr int FFH = 2816;
constexpr float ALPHA = 1.6817928305074290f;

constexpr size_t OFF_BTIN = 0;
constexpr size_t OFF_BTFI = OFF_BTIN + (size_t)NIN * 1024 * 2;
constexpr size_t OFF_BTFO = OFF_BTFI + (size_t)NIN * 1024 * 2;
constexpr size_t OFF_BTWO = OFF_BTFO + (size_t)1024 * FFH * 2;
constexpr size_t OFF_BTBR = OFF_BTWO + (size_t)1024 * 1024 * 2;
constexpr size_t OFF_BTGLU = OFF_BTBR + (size_t)1024 * 1536 * 2;
constexpr size_t OFF_BTC1 = OFF_BTGLU + (size_t)1024 * 512 * 2;
constexpr size_t OFF_BTC2 = OFF_BTC1 + (size_t)2 * 256 * 2048 * 2;
constexpr size_t OFF_BTPOOL = OFF_BTC2 + (size_t)2 * 64 * 256 * 2;
constexpr size_t OFF_WC = OFF_BTPOOL + (size_t)4 * 128 * 128 * 2;
constexpr size_t OFF_W1 = OFF_WC + (size_t)32 * 256 * 384 * 2;
constexpr size_t OFF_LAM16 = OFF_W1 + (size_t)32 * 128 * 256 * 2;
constexpr size_t OFF_CB1 = OFF_LAM16 + (size_t)32 * 64 * 8;
constexpr size_t OFF_ROPE = OFF_CB1 + 4096;
constexpr size_t OFF_XH = OFF_ROPE + (size_t)T_ * 32 * 8;
constexpr size_t OFF_SP = OFF_XH;

constexpr size_t OFF_BRG = OFF_XH + (size_t)T_ * 1024 * 2;
constexpr size_t OFF_HFF = OFF_BRG;
constexpr size_t OFF_YBR = OFF_BRG + (size_t)T_ * 3072 * 2;
constexpr size_t OFF_USSM = OFF_YBR + (size_t)T_ * 1536 * 2;
constexpr size_t OFF_UPOOL = OFF_USSM + (size_t)32 * 1024 * 384 * 2;
constexpr size_t OFF_YGELU = OFF_UPOOL;
constexpr size_t OFF_Q = OFF_UPOOL + (size_t)T_ * 512 * 2;
constexpr size_t OFF_KV = OFF_Q + (size_t)T_ * 512 * 2;
constexpr size_t SZ_KV1 = (size_t)2 * T_ * 64 * 2;
constexpr size_t OFF_NSAG = OFF_KV + 6 * SZ_KV1 + 65536;
constexpr size_t OFF_HG = OFF_NSAG + (size_t)T_ * 24 * 4;
constexpr size_t OFF_KCOMP = OFF_HG + (size_t)4 * 1024 * 256 * 2;
constexpr size_t OFF_ETAB = OFF_KCOMP + (size_t)2 * 8 * 2 * 128 * 64 * 2;
constexpr size_t OFF_BAR = OFF_ETAB + (size_t)DEPTH_ * 2048 * 18 * 8;
constexpr size_t OFF_XS = OFF_BAR + 32768;
constexpr size_t OFF_POOLED = OFF_XS + (size_t)64 * 256 * 4 * 8;
constexpr size_t OFF_MERGED = OFF_Q;
constexpr size_t NINA = 2560, NINB = 3072;
constexpr size_t WS_TOTAL = OFF_POOLED + (size_t)T_ * 512 * 2;
static_assert(WS_TOTAL < (size_t)352 * 1024 * 1024, "workspace too large");

struct P {
  const float* x; const int* pos; const float* w_in; const float* a_re; const float* a_im; const float* log_dt;
  const float* b_re; const float* b_im; const float* c_re; const float* c_im; const float* ssm_d; const float* w_glu;
  const float* pool_w; const float* pool_scale; const float* cmp_pos; const float* cmp_w1; const float* cmp_b1; const float* cmp_w2;
  const float* w_branch; const float* w_out; const float* ln_g; const float* ln_b; const float* ffn_w_in; const float* ffn_w_out;
  float* out; char* ws;
};

DEVI float frcp(float x) { return __builtin_amdgcn_rcpf(x); }
DEVI float sigmoidf_(float x) { return frcp(1.0f + __expf(-x)); }
DEVI float gelu_tanh(float x) { const float u = 0.7978845608028654f * (x + 0.044715f * x * x * x); return x * frcp(1.0f + __expf(-2.0f * u)); }
DEVI h4 pack4(f4 v) { h4 r; r[0] = (hf)v[0]; r[1] = (hf)v[1]; r[2] = (hf)v[2]; r[3] = (hf)v[3]; return r; }


#define XB_TMO      128
#define XB_XCNT(j)  (256  + 64 * (j))
#define XB_XSUB(j)  (1280 + 64 * (j))
#define XB_XGEN(j)  (2304 + 64 * (j))
#define XB_TOP      3328
#define XB_TOPGEN   3392
#define XCD_BAR_WORDS 3456
#define XB_SPIN_CAP (1u << 20)
#define LAS __attribute__((address_space(3)))
DEVI unsigned xb_ld(unsigned* p)              { return __hip_atomic_load(p, __ATOMIC_RELAXED, __HIP_MEMORY_SCOPE_AGENT); }
DEVI unsigned xb_add(unsigned* p, unsigned v) { return __hip_atomic_fetch_add(p, v, __ATOMIC_RELAXED, __HIP_MEMORY_SCOPE_AGENT); }
DEVI unsigned xb_xcc_id() { return (unsigned)__builtin_amdgcn_s_getreg((3 << 11) | 20) & 0xFu; }
#define XB_SPIN(cond, bar) do { unsigned _sp = 0; while (cond) { __builtin_amdgcn_s_sleep(1); \
    if ((++_sp & 255u) == 0u) { if (xb_ld(&(bar)[XB_TMO])) break; if (_sp > XB_SPIN_CAP) { atomicAdd(&(bar)[XB_TMO], 1u); break; } } } } while (0)
struct XcdBarrier { unsigned* bar; unsigned x; volatile LAS unsigned* st; };
DEVI XcdBarrier xcd_barrier_post(unsigned* bar, volatile LAS unsigned* st) {
  XcdBarrier b; b.bar = bar; b.x = xb_xcc_id(); b.st = st;
  if (threadIdx.x == 0) (void)xb_add(&bar[XB_XCNT(b.x)], 1u);
  return b;
}
DEVI void xcd_barrier_complete(unsigned* bar, unsigned x, unsigned& nloc, unsigned& nx) {
  const unsigned G = gridDim.x * gridDim.y * gridDim.z;
  unsigned sum, cnt, mine, sp = 0u;
  for (;;) {
    sum = 0u; cnt = 0u; mine = 0u;
#pragma unroll
    for (unsigned j = 0; j < 16; ++j) { const unsigned c = xb_ld(&bar[XB_XCNT(j)]); sum += c; cnt += (c > 0u) ? 1u : 0u; mine = (j == x) ? c : mine; }
    if (sum == G) break;
    __builtin_amdgcn_s_sleep(1);
    if ((++sp & 255u) == 0u) { if (xb_ld(&bar[XB_TMO])) break; if (sp > XB_SPIN_CAP) { atomicAdd(&bar[XB_TMO], 1u); break; } }
  }
  nloc = mine > 0u ? mine : 1u; nx = cnt > 0u ? cnt : 1u;
}
DEVI void xcd_barrier(const XcdBarrier& b) {
  asm volatile("s_waitcnt vmcnt(0)" ::: "memory");
  __syncthreads();
  if (threadIdx.x == 0) {
    unsigned* bar = b.bar;
    __builtin_amdgcn_s_waitcnt(0);
    unsigned nloc = b.st[0], nx = b.st[1];
    if (nloc == 0u) { xcd_barrier_complete(bar, b.x, nloc, nx); b.st[0] = nloc; b.st[1] = nx; }
    const unsigned old = xb_add(&bar[XB_XSUB(b.x)], 1u);
    const unsigned gen = old / nloc;
    if (old + 1u == (gen + 1u) * nloc) {
      __builtin_amdgcn_fence(__ATOMIC_RELEASE, "agent");
      asm volatile("s_waitcnt vmcnt(0)" ::: "memory");
      const unsigned og = xb_add(&bar[XB_TOP], 1u);
      const unsigned tg = og / nx;
      if (og + 1u == (tg + 1u) * nx) xb_add(&bar[XB_TOPGEN], 1u);
      else XB_SPIN(xb_ld(&bar[XB_TOPGEN]) == tg, bar);
      __builtin_amdgcn_fence(__ATOMIC_ACQUIRE, "agent");
      xb_add(&bar[XB_XGEN(b.x)], 1u);
      asm volatile("s_waitcnt vmcnt(0)" ::: "memory");
    } else {
      XB_SPIN(xb_ld(&bar[XB_XGEN(b.x)]) == gen, bar);
      __builtin_amdgcn_fence(__ATOMIC_ACQUIRE, "agent");
      asm volatile("s_waitcnt vmcnt(0)" ::: "memory");
    }
  }
  __syncthreads();
}

constexpr int BM = 256, BK = 64, HALFT = 128, HT = HALFT * BK;
DEVI int lds_byte(int r, int c) { int st = (r >> 4) * 2 + (c >> 5), rr = r & 15, cc = c & 31, ob = rr * 64 + cc * 2; return st * 1024 + (ob ^ (((ob >> 9) & 1) << 5)); }
DEVI void stage_rc(int b, int& R, int& C) { int st = b / 1024, sb = b % 1024, swz = sb ^ (((sb >> 9) & 1) << 5); R = (st >> 1) * 16 + swz / 64; C = (st & 1) * 32 + (swz % 64) / 2; }

struct NoHook { DEVI void operator()(f4 (&)[2][2][4][2], int, int, int, int, int, int, int) const {} };

template <class Epi, class Hook>
DEVI void gemm256(const hf* __restrict__ A, int lda, const hf* __restrict__ Bt, int ldb, int K, int nM, int nN, char* smem, const Epi& epi, const Hook& hook) {
  LAS unsigned char* lds = (LAS unsigned char*)smem;
  constexpr int HTB = HT * 2;
  const int tid = otid(), wid = __builtin_amdgcn_readfirstlane(tid >> 6), lane = tid & 63, wr = wid >> 2, wc = wid & 3, fr = lane & 15, fq = lane >> 4;
  unsigned voffA[2], voffB[2];
#pragma unroll
  for (int i = 0; i < 2; ++i) { int R, C; stage_rc(tid * 16 + i * 8192, R, C); voffA[i] = (unsigned)(R * lda + C) * 2u; voffB[i] = (unsigned)(R * ldb + C) * 2u; }
  const int kstep = BK * 2, hstepA = HALFT * lda * 2, hstepB = HALFT * ldb * 2;
  const __amdgpu_buffer_rsrc_t rA = __builtin_amdgcn_make_buffer_rsrc((void*)A, (short)0, 0x7fffffff, 0x00020000), rB = __builtin_amdgcn_make_buffer_rsrc((void*)Bt, (short)0, 0x7fffffff, 0x00020000);
  const unsigned ldsw = (unsigned)wid * 1024u;
  const int aoff = lds_byte(wr * 64 + fr, fq * 8), boff = lds_byte(wc * 32 + fr, fq * 8);
#define SA(b, h) (((b) * 2 + (h)) * HTB)
#define SB(b, h) ((4 + (b) * 2 + (h)) * HTB)
#define STAGE(bufoff, gbase, voff) do { _Pragma("unroll") for (int _i = 0; _i < 2; ++_i) \
    __builtin_amdgcn_raw_ptr_buffer_load_lds((&(voff)[0] == &voffA[0]) ? rA : rB, (LAS void*)(lds + (bufoff) + ldsw + _i * 8192), 16, (voff)[_i], (int)(gbase), 0, 0); } while (0)
#define LDA(dst, b, h) do { _Pragma("unroll") for (int m = 0; m < 4; ++m) _Pragma("unroll") for (int k = 0; k < 2; ++k) dst[m][k] = *(const LAS h8*)(lds + SA(b, h) + aoff + m * 2048 + k * 1024); } while (0)
#define LDB(dst, b, h) do { _Pragma("unroll") for (int n = 0; n < 2; ++n) _Pragma("unroll") for (int k = 0; k < 2; ++k) dst[n][k] = *(const LAS h8*)(lds + SB(b, h) + boff + n * 2048 + k * 1024); } while (0)
#define MMA(ai, bj, At_, Bt_) do { __builtin_amdgcn_s_setprio(1); \
    _Pragma("unroll") for (int m = 0; m < 4; ++m) _Pragma("unroll") for (int n = 0; n < 2; ++n) _Pragma("unroll") for (int k = 0; k < 2; ++k) \
      acc[ai][bj][m][n] = __builtin_amdgcn_mfma_f32_16x16x32_f16(Bt_[n][k], At_[m][k], acc[ai][bj][m][n], 0, 0, 0); \
    __builtin_amdgcn_s_setprio(0); } while (0)
#define WAIT_V(n) asm volatile("s_waitcnt vmcnt(" #n ")" ::: "memory")
#define WAIT_L(n) asm volatile("s_waitcnt lgkmcnt(" #n ")" ::: "memory")
#define BAR __builtin_amdgcn_s_barrier()
#define SCHED __builtin_amdgcn_sched_barrier(0)
  const int nwg = nM * nN;
  const int nt = K / BK;
  for (int L = obid(); L < nwg; L += gridDim.x) {
    int wgid = L;
    { const int q = nwg / 8, r = nwg % 8, xcd = wgid % 8, off = wgid / 8; wgid = (xcd < r ? xcd * (q + 1) : r * (q + 1) + (xcd - r) * q) + off; }
    const int WG_ = nN >= 16 ? 2 : 4;
    const int nig = WG_ * nN, gid = wgid / nig, fm = gid * WG_, gsz = min(nM - fm, WG_);
    const int pm = fm + ((wgid % nig) % gsz), pn = (wgid % nig) / gsz, brow = pm * BM, bcol = pn * BM;
    const int cA = brow * lda * 2, cB = bcol * ldb * 2;
    __syncthreads();
    f4 acc[2][2][4][2];
#pragma unroll
    for (int a = 0; a < 2; ++a)
#pragma unroll
      for (int b = 0; b < 2; ++b)
#pragma unroll
        for (int m = 0; m < 4; ++m)
#pragma unroll
          for (int n = 0; n < 2; ++n) acc[a][b][m][n] = (f4){0.f, 0.f, 0.f, 0.f};
    h8 At[4][2], B0[2][2], B1[2][2];
    STAGE(SB(0, 0), cB, voffB); STAGE(SA(0, 0), cA, voffA); STAGE(SB(0, 1), cB + hstepB, voffB); STAGE(SA(0, 1), cA + hstepA, voffA);
    if (wr == 1) BAR;
    WAIT_V(4); BAR;
    STAGE(SB(1, 0), cB + kstep, voffB); STAGE(SA(1, 0), cA + kstep, voffA); STAGE(SB(1, 1), cB + hstepB + kstep, voffB);
    WAIT_V(6); BAR;
    for (int t = 0; t < nt - 2; t += 2) {
      hook(acc, t, brow, bcol, wr, wc, fr, fq);
      const int a1 = cA + (t + 1) * kstep, a2 = a1 + kstep, a3 = a2 + kstep;
      const int b2 = cB + (t + 2) * kstep, b3 = b2 + kstep;
      LDB(B0, 0, 0); SCHED; LDA(At, 0, 0); STAGE(SA(1, 1), a1 + hstepA, voffA);
      WAIT_L(8); BAR; WAIT_L(0); MMA(0, 0, At, B0); BAR; SCHED;
      LDB(B1, 0, 1); STAGE(SB(0, 0), b2, voffB);
      BAR; WAIT_L(0); MMA(0, 1, At, B1); BAR;
      LDA(At, 0, 1); STAGE(SA(0, 0), a2, voffA);
      BAR; WAIT_L(0); MMA(1, 0, At, B0); BAR; SCHED;
      STAGE(SB(0, 1), b2 + hstepB, voffB);
      WAIT_V(6); BAR; MMA(1, 1, At, B1); BAR;
      LDB(B0, 1, 0); SCHED; LDA(At, 1, 0); STAGE(SA(0, 1), a2 + hstepA, voffA);
      WAIT_L(8); BAR; WAIT_L(0); MMA(0, 0, At, B0); BAR; SCHED;
      LDB(B1, 1, 1); STAGE(SB(1, 0), b3, voffB);
      BAR; WAIT_L(0); MMA(0, 1, At, B1); BAR;
      LDA(At, 1, 1); STAGE(SA(1, 0), a3, voffA);
      BAR; WAIT_L(0); MMA(1, 0, At, B0); BAR; SCHED;
      STAGE(SB(1, 1), b3 + hstepB, voffB);
      WAIT_V(6); BAR; MMA(1, 1, At, B1); BAR;
    }
    { LDB(B0, 0, 0); LDA(At, 0, 0); STAGE(SA(1, 1), cA + (nt - 1) * kstep + hstepA, voffA);
      BAR; WAIT_L(0); MMA(0, 0, At, B0); BAR;
      LDB(B1, 0, 1); BAR; WAIT_L(0); MMA(0, 1, At, B1); BAR;
      LDA(At, 0, 1); WAIT_V(4); BAR; WAIT_L(0); MMA(1, 0, At, B0); MMA(1, 1, At, B1); BAR; }
    { LDB(B0, 1, 0); LDA(At, 1, 0); WAIT_V(2); BAR; WAIT_L(0); MMA(0, 0, At, B0); BAR;
      LDB(B1, 1, 1); WAIT_V(0); BAR; WAIT_L(0); MMA(0, 1, At, B1); BAR;
      LDA(At, 1, 1); BAR; WAIT_L(0); MMA(1, 0, At, B0); MMA(1, 1, At, B1); BAR; }
    if (wr == 0) BAR;
    { int fr2 = fr, fq2 = fq, brow2 = brow, bcol2 = bcol; asm volatile("" : "+v"(fr2), "+v"(fq2)); asm volatile("" : "+s"(brow2), "+s"(bcol2));
      epi(acc, brow2, bcol2, wr, wc, fr2, fq2); }
  }
#undef SA
#undef SB
}

template <int MT, class AF, class BF, class EF>
DEVI void sgemm_tile(int K, const AF& af, const BF& bf, const EF& ef, char* smem) {
  hf* As = (hf*)smem;
  hf* Bs = As + 64 * MT * 136;
  const int tid = otid(), w = __builtin_amdgcn_readfirstlane(tid >> 6), lane = tid & 63, wr = w >> 1, wc = w & 1, fr = lane & 15, fq = lane >> 4;
  const int lr = tid >> 4, lk = (tid & 15) * 8;
  f4 acc[MT][2];
#pragma unroll
  for (int m = 0; m < MT; ++m)
#pragma unroll
    for (int n = 0; n < 2; ++n) acc[m][n] = (f4){0.f, 0.f, 0.f, 0.f};
  h8 ra[2 * MT], rb[2];
#pragma unroll
  for (int i = 0; i < 2 * MT; ++i) ra[i] = *(const h8*)af(lr + 32 * i, lk);
#pragma unroll
  for (int i = 0; i < 2; ++i) rb[i] = *(const h8*)bf(lr + 32 * i, lk);
  for (int k0 = 0; k0 < K; k0 += 128) {
    __syncthreads();
#pragma unroll
    for (int i = 0; i < 2 * MT; ++i) *(h8*)(As + (lr + 32 * i) * 136 + lk) = ra[i];
#pragma unroll
    for (int i = 0; i < 2; ++i) *(h8*)(Bs + (lr + 32 * i) * 136 + lk) = rb[i];
    __syncthreads();
    if (k0 + 128 < K) {
#pragma unroll
      for (int i = 0; i < 2 * MT; ++i) ra[i] = *(const h8*)af(lr + 32 * i, k0 + 128 + lk);
#pragma unroll
      for (int i = 0; i < 2; ++i) rb[i] = *(const h8*)bf(lr + 32 * i, k0 + 128 + lk);
    }
#pragma unroll
    for (int ks = 0; ks < 4; ++ks) {
      h8 a[MT], b[2];
#pragma unroll
      for (int m = 0; m < MT; ++m) a[m] = *(const h8*)(As + (wr * 16 * MT + m * 16 + fr) * 136 + ks * 32 + fq * 8);
#pragma unroll
      for (int n = 0; n < 2; ++n) b[n] = *(const h8*)(Bs + (wc * 32 + n * 16 + fr) * 136 + ks * 32 + fq * 8);
#pragma unroll
      for (int m = 0; m < MT; ++m)
#pragma unroll
        for (int n = 0; n < 2; ++n) acc[m][n] = __builtin_amdgcn_mfma_f32_16x16x32_f16(b[n], a[m], acc[m][n], 0, 0, 0);
    }
  }
#pragma unroll
  for (int m = 0; m < MT; ++m)
#pragma unroll
    for (int n = 0; n < 2; ++n) ef(wr * 16 * MT + m * 16 + fr, wc * 32 + n * 16 + fq * 4, acc[m][n]);
}

DEVI int srccol(int map, int n) {
  if (map == 0) {
    const int hc = n >> 7, pc = n & 127;
    int lc = pc;
    if ((hc >= 8 && hc <= 12) || hc == 14 || hc == 16) { const int wc = pc >> 5, nn = (pc >> 4) & 1, q = pc & 15; lc = (wc >> 1) * 64 + (wc & 1) * 16 + q + 32 * nn; }
    if (hc < 18) return hc * 128 + lc;
    if (hc == 18) return lc < 24 ? 2304 + lc : -1;
    return -1;
  }
  if (map == 3) return 2328 + n;
  if (map == 1) { const int pn = n >> 8, bj = (n >> 7) & 1, i = n & 127; return bj * 512 + pn * 128 + i; }
  if (map == 2) { const int pn = n >> 8, bj = (n >> 7) & 1, i = n & 127, wc = i >> 5, nn = (i >> 4) & 1, q = i & 15;
                  return bj * FFH + pn * 128 + wc * 32 + (q >> 2) * 8 + nn * 4 + (q & 3); }
  return n;
}

DEVI void tconv(const float* __restrict__ src, int ldS, hf* __restrict__ dst, int ldD, int Kr, int Np, int map, int& rot, char* smem) {
  hf* tl = (hf*)smem;
  const int nkt = Kr / 64, nnt = Np / 64, tid = otid(), ntl = nkt * nnt;
  const int G = gridDim.x;
  const int first = (int)((obid() + G - (rot % G)) % G);
  rot += ntl;
  for (int tIdx = first; tIdx < ntl; tIdx += G) {
    const int kt = tIdx % nkt, ntile = tIdx / nkt;
    const int n = tid & 63, kk = tid >> 6;
    const int sc = srccol(map, ntile * 64 + n);
    __syncthreads();
#pragma unroll
    for (int i = 0; i < 8; ++i) { const int k = i * 8 + kk; const float v = sc >= 0 ? src[(size_t)(kt * 64 + k) * ldS + sc] : 0.f; tl[k * 66 + n] = (hf)v; }
    __syncthreads();
    const int n2 = tid >> 3, k8 = (tid & 7) * 8;
    h8 o;
#pragma unroll
    for (int i = 0; i < 8; ++i) o[i] = tl[(k8 + i) * 66 + n2];
    *(h8*)(dst + (size_t)(ntile * 64 + n2) * ldD + kt * 64 + k8) = o;
  }
}

DEVI void tconv_big(const float* __restrict__ src, int ldS, hf* __restrict__ dst, int ldD, int Kr, int Np, int map, int& rot, char* smem) {
  hf* tl = (hf*)smem;
  const int nkt = Kr / 64, nnt = Np / 256, tid = otid(), ntl = nkt * nnt;
  const int G = gridDim.x;
  const int first = (int)((obid() + G - (rot % G)) % G);
  rot += ntl;
  for (int tIdx = first; tIdx < ntl; tIdx += G) {
    const int kt = tIdx % nkt, ntile = tIdx / nkt;
    const int n4 = (tid & 63) * 4, kk = tid >> 6;
    const int sc = srccol(map, ntile * 256 + n4);
    f4 v[8];
#pragma unroll
    for (int i = 0; i < 8; ++i) v[i] = sc >= 0 ? *(const f4*)(src + (size_t)(kt * 64 + i * 8 + kk) * ldS + sc) : (f4){0.f, 0.f, 0.f, 0.f};
    __syncthreads();
#pragma unroll
    for (int i = 0; i < 8; ++i) *(h4*)(tl + (i * 8 + kk) * 264 + n4) = pack4(v[i]);
    __syncthreads();
#pragma unroll
    for (int q = 0; q < 4; ++q) {
      const int n2 = (tid >> 3) + q * 64, k8 = (tid & 7) * 8;
      h8 o;
#pragma unroll
      for (int i = 0; i < 8; ++i) o[i] = tl[(k8 + i) * 264 + n2];
      *(h8*)(dst + (size_t)(ntile * 256 + n2) * ldD + kt * 64 + k8) = o;
    }
  }
}

DEVI void lampow(float ar, float ai, double dt, int n, double& re, double& im) {
  const double m = exp((double)ar * dt * n), ang = (double)ai * dt * n;
  re = m * cos(ang); im = m * sin(ang);
}
DEVI void zohcoef(float ar, float ai, double dt, double& re, double& im) {
  double lr, li; lampow(ar, ai, dt, 1, lr, li);
  const double nr = lr - 1.0, ni = li, dr = (double)ar, di = (double)ai, den = dr * dr + di * di;
  re = (nr * dr + ni * di) / den; im = (ni * dr - nr * di) / den;
}

DEVI void w_ffo(const P& p, int l, char* smem) {
  int rot = 0;
  tconv_big(p.ffn_w_out + (size_t)l * FFH * 1024, 1024, (hf*)(p.ws + OFF_BTFO), FFH, FFH, 1024, 9, rot, smem);
}
DEVI void phase_w(const P& p, int l, char* smem) {
  char* ws = p.ws;
  int rot = 0;
  tconv_big(p.w_in + (size_t)l * 1024 * 5400, 5400, (hf*)(ws + OFF_BTIN), 1024, 1024, (int)NINA, 0, rot, smem);
  tconv_big(p.w_in + (size_t)l * 1024 * 5400, 5400, (hf*)(ws + OFF_BTIN) + NINA * 1024, 1024, 1024, (int)NINB, 3, rot, smem);
  tconv_big(p.ffn_w_in + (size_t)l * 1024 * 5632, 5632, (hf*)(ws + OFF_BTFI), 1024, 1024, 5632, 2, rot, smem);
  tconv_big(p.w_out + (size_t)l * 1024 * 1024, 1024, (hf*)(ws + OFF_BTWO), 1024, 1024, 1024, 9, rot, smem);
  for (int k = 0; k < 3; ++k) tconv_big(p.w_branch + ((size_t)l * 3 + k) * 512 * 1024, 1024, (hf*)(ws + OFF_BTBR) + k * 512, 1536, 512, 1024, 9, rot, smem);
  tconv_big(p.w_glu + (size_t)l * 512 * 1024, 1024, (hf*)(ws + OFF_BTGLU), 512, 512, 1024, 1, rot, smem);
  for (int j = 0; j < 2; ++j) tconv_big(p.cmp_w1 + ((size_t)l * 2 + j) * 2048 * 256, 256, (hf*)(ws + OFF_BTC1) + (size_t)j * 256 * 2048, 2048, 2048, 256, 9, rot, smem);
  for (int j = 0; j < 2; ++j) tconv(p.cmp_w2 + ((size_t)l * 2 + j) * 256 * 64, 64, (hf*)(ws + OFF_BTC2) + (size_t)j * 64 * 256, 256, 256, 64, 9, rot, smem);
  for (int g = 0; g < 4; ++g) tconv(p.pool_w + ((size_t)l * 4 + g) * 128 * 128, 128, (hf*)(ws + OFF_BTPOOL) + (size_t)g * 128 * 128, 128, 128, 128, 9, rot, smem);

  const int gtid = obid() * 512 + otid(), gnt = gridDim.x * 512;
    const float* bre = p.b_re + (size_t)l * 32768; const float* bim = p.b_im + (size_t)l * 32768;
  const float* cre = p.c_re + (size_t)l * 32768; const float* cim = p.c_im + (size_t)l * 32768;
  hf* WC = (hf*)(ws + OFF_WC); hf* W1 = (hf*)(ws + OFF_W1); float* LAM16 = (float*)(ws + OFF_LAM16);
  const f2* E = (const f2*)(ws + OFF_ETAB) + (size_t)l * 2048 * 18;
  const float* DT = (const float*)(ws + OFF_CB1 + 2048) + l * 32;
  for (int idx = gtid; idx < 32 * 16 * 256; idx += gnt) {
    const int ci = idx & 15, co = (idx >> 4) & 15, d = (idx >> 8) & 15, g = idx >> 12;
    const float dt = DT[g];
    float sum = 0.f;
    for (int pp = 0; pp < 64; ++pp) {
      const f2 z = E[(g * 64 + pp) * 18 + 17], e = E[(g * 64 + pp) * 18 + d];
      const float br = bre[(g * 64 + pp) * 16 + ci], bi = bim[(g * 64 + pp) * 16 + ci];
      const float bbr = z[0] * br - z[1] * bi, bbi = z[0] * bi + z[1] * br;
      const float tr = e[0] * bbr - e[1] * bbi, ti = e[0] * bbi + e[1] * bbr;
      sum += cre[(g * 16 + co) * 64 + pp] * tr - cim[(g * 16 + co) * 64 + pp] * ti;
    }
    const hf v = (hf)(sum / dt);
    for (int t = d; t < 16; ++t) WC[((size_t)g * 256 + t * 16 + co) * 384 + (t - d) * 16 + ci] = v;
    if (d >= 1) for (int t = 0; t + d < 16; ++t) WC[((size_t)g * 256 + t * 16 + co) * 384 + (t + d) * 16 + ci] = (hf)0.f;
  }
  for (int idx = gtid; idx < 32 * 16 * 16 * 64; idx += gnt) {
    const int pp = idx & 63, co = (idx >> 6) & 15, t = (idx >> 10) & 15, g = idx >> 14;
    const f2 e = E[(g * 64 + pp) * 18 + t + 1];
    const float cr = cre[(g * 16 + co) * 64 + pp], cii = cim[(g * 16 + co) * 64 + pp];
    WC[((size_t)g * 256 + t * 16 + co) * 384 + 256 + pp] = (hf)(cr * e[0] - cii * e[1]);
    WC[((size_t)g * 256 + t * 16 + co) * 384 + 320 + pp] = (hf)(-(cr * e[1] + cii * e[0]));
  }
  for (int idx = gtid; idx < 32 * 64 * 256; idx += gnt) {
    const int ci = idx & 15, j = (idx >> 4) & 15, pp = (idx >> 8) & 63, g = idx >> 14;
    const float dt = DT[g];
    const f2 z = E[(g * 64 + pp) * 18 + 17], e = E[(g * 64 + pp) * 18 + 15 - j];
    const float br = bre[(g * 64 + pp) * 16 + ci], bi = bim[(g * 64 + pp) * 16 + ci];
    const float bbr = z[0] * br - z[1] * bi, bbi = z[0] * bi + z[1] * br;
    W1[((size_t)g * 128 + pp) * 256 + j * 16 + ci] = (hf)((e[0] * bbr - e[1] * bbi) / dt);
    W1[((size_t)g * 128 + 64 + pp) * 256 + j * 16 + ci] = (hf)((e[0] * bbi + e[1] * bbr) / dt);
  }
  for (int idx = gtid; idx < 2048; idx += gnt) { const f2 e = E[idx * 18 + 16]; LAM16[idx * 2] = e[0]; LAM16[idx * 2 + 1] = e[1]; }
  {
    float* red = (float*)(smem + 40960);
    float* CB1 = (float*)(ws + OFF_CB1);
    for (int job = obid(); job < 64; job += gridDim.x) {
      const int tj = otid(); const int j = job >> 5, cg8 = job & 31, c = tj & 7, kl = tj >> 3;
      const float* w1 = p.cmp_w1 + ((size_t)l * 2 + j) * 2048 * 256; const float* ps = p.cmp_pos + ((size_t)l * 2 + j) * 2048;
      float s = 0.f;
      for (int k = kl; k < 2048; k += 64) s += ps[k] * w1[(size_t)k * 256 + cg8 * 8 + c];
      __syncthreads();
      red[kl * 8 + c] = s;
      __syncthreads();
      if (tj < 8) { float tot = 0.f; for (int i = 0; i < 64; ++i) tot += red[i * 8 + tj]; CB1[j * 256 + cg8 * 8 + tj] = tot + p.cmp_b1[(l * 2 + j) * 256 + cg8 * 8 + tj]; }
    }
  }
}

DEVI void phase_0(const P& p) {
  const int gtid = obid() * 512 + otid(), gnt = gridDim.x * 512;
  f2* rope = (f2*)(p.ws + OFF_ROPE);
  for (int idx = gtid; idx < T_ * 32; idx += gnt) {
    const int i = idx & 31, t = idx >> 5;
    const double inv = exp(-(double)i * (9.210340371976184 / 32.0));
    const double ang = (double)p.pos[t] * inv;
    rope[idx] = (f2){(float)cos(ang), (float)sin(ang)};
  }
  f2* ET = (f2*)(p.ws + OFF_ETAB);
  for (int idx = gtid; idx < DEPTH_ * 2048 * 18; idx += gnt) {
    const int d = idx % 18, gp = idx / 18;
    const double dt = exp((double)p.log_dt[gp >> 6]);
    double re, im;
    if (d < 17) lampow(p.a_re[gp], p.a_im[gp], dt, d, re, im); else zohcoef(p.a_re[gp], p.a_im[gp], dt, re, im);
    ET[idx] = (f2){(float)re, (float)im};
  }
  if (gtid < DEPTH_ * 32) ((float*)(p.ws + OFF_CB1 + 2048))[gtid] = (float)exp((double)p.log_dt[gtid]);
  hf* XH = (hf*)(p.ws + OFF_XH);
  for (int idx = gtid; idx < T_ * 1024 / 4; idx += gnt) { const f4 v = ((const f4*)p.x)[idx]; *(h4*)(XH + (size_t)idx * 4) = pack4(v); }
}

DEVI void phase_ln(float* X, hf* XH, const float* __restrict__ g, const float* __restrict__ b) {
  const int tid_ = otid(), lane = tid_ & 63, gw = obid() * 8 + (tid_ >> 6), nw = gridDim.x * 8;
  for (int row = gw; row < T_; row += nw) {
    float* xr = X + (size_t)row * 1024;
    f4 v[4];
    float s = 0.f;
#pragma unroll
    for (int i = 0; i < 4; ++i) { v[i] = *(const f4*)(xr + i * 256 + lane * 4); s += (v[i][0] + v[i][1]) + (v[i][2] + v[i][3]); }
#pragma unroll
    for (int o = 32; o >= 1; o >>= 1) s += __shfl_xor(s, o);
    const float mu = s * (1.0f / 1024.0f);
    float q = 0.f;
#pragma unroll
    for (int i = 0; i < 4; ++i) { const f4 d = v[i] - mu; q += (d[0] * d[0] + d[1] * d[1]) + (d[2] * d[2] + d[3] * d[3]); }
#pragma unroll
    for (int o = 32; o >= 1; o >>= 1) q += __shfl_xor(q, o);
    const float rstd = rsqrtf(q * (1.0f / 1024.0f) + 1e-5f);
#pragma unroll
    for (int i = 0; i < 4; ++i) {
      const f4 gg = *(const f4*)(g + i * 256 + lane * 4), bb = *(const f4*)(b + i * 256 + lane * 4);
      const f4 y = (v[i] - mu) * rstd * gg + bb;
      *(f4*)(xr + i * 256 + lane * 4) = y;
      *(h4*)(XH + (size_t)row * 1024 + i * 256 + lane * 4) = pack4(y);
    }
  }
}

struct EpiIn {
  char* ws;
  DEVI void operator()(const f4 (&acc)[2][2][4][2], int brow, int bcol, int wr, int wc, int fr, int fq) const {
    const f2* rope = (const f2*)(ws + OFF_ROPE);
#pragma unroll
    for (int bj = 0; bj < 2; ++bj) {
      const int hc = (bcol >> 7) + bj;
      if (hc < 4) {
        hf* U = (hf*)(ws + OFF_USSM);
#pragma unroll
        for (int ai = 0; ai < 2; ++ai)
#pragma unroll
          for (int m = 0; m < 4; ++m) {
            __builtin_amdgcn_sched_barrier(0); const int t = brow + ai * 128 + wr * 64 + m * 16 + fr;
#pragma unroll
            for (int n = 0; n < 2; ++n) *(h4*)(U + ((size_t)(hc * 8 + wc * 2 + n) * 1024 + (t >> 4)) * 384 + (t & 15) * 16 + fq * 4) = pack4(acc[ai][bj][m][n]);
          }
      } else if (hc < 8) {
        hf* U = (hf*)(ws + OFF_UPOOL);
#pragma unroll
        for (int ai = 0; ai < 2; ++ai)
#pragma unroll
          for (int m = 0; m < 4; ++m) {
            __builtin_amdgcn_sched_barrier(0); const int t = brow + ai * 128 + wr * 64 + m * 16 + fr;
#pragma unroll
            for (int n = 0; n < 2; ++n) *(h4*)(U + (size_t)t * 512 + (hc - 4) * 128 + wc * 32 + n * 16 + fq * 4) = pack4(acc[ai][bj][m][n]);
          }
      } else if (hc < 18) {
        const bool isq = hc < 12;
        const int kvi = hc - 12;
        const bool dorope = isq || ((kvi & 1) == 0);
#pragma unroll
        for (int ai = 0; ai < 2; ++ai)
#pragma unroll
          for (int m = 0; m < 4; ++m) {
            __builtin_amdgcn_sched_barrier(0); const int t = brow + ai * 128 + wr * 64 + m * 16 + fr;
            hf* dst = isq ? (hf*)(ws + OFF_Q) + (size_t)t * 512 + ((hc - 8) * 2 + (wc >> 1)) * 64
                          : (hf*)(ws + OFF_KV + (size_t)kvi * SZ_KV1) + ((size_t)(wc >> 1) * T_ + t) * 64;
            const f4 v0 = acc[ai][bj][m][0], v1 = acc[ai][bj][m][1];
            if (dorope) {
              const int d1 = (wc & 1) * 16 + fq * 4;
              const f4 cs0 = *(const f4*)(rope + (size_t)t * 32 + d1), cs1 = *(const f4*)(rope + (size_t)t * 32 + d1 + 2);
              f4 o1, o2;
              o1[0] = v0[0] * cs0[0] - v1[0] * cs0[1]; o2[0] = v0[0] * cs0[1] + v1[0] * cs0[0];
              o1[1] = v0[1] * cs0[2] - v1[1] * cs0[3]; o2[1] = v0[1] * cs0[3] + v1[1] * cs0[2];
              o1[2] = v0[2] * cs1[0] - v1[2] * cs1[1]; o2[2] = v0[2] * cs1[1] + v1[2] * cs1[0];
              o1[3] = v0[3] * cs1[2] - v1[3] * cs1[3]; o2[3] = v0[3] * cs1[3] + v1[3] * cs1[2];
              *(h4*)(dst + d1) = pack4(o1); *(h4*)(dst + d1 + 32) = pack4(o2);
            } else {
              const int d = (wc & 1) * 32 + fq * 4;
              *(h4*)(dst + d) = pack4(v0); *(h4*)(dst + d + 16) = pack4(v1);
            }
          }
      } else if (hc == 18) {
        float* NG = (float*)(ws + OFF_NSAG);
        if (wc == 0) {
#pragma unroll
          for (int ai = 0; ai < 2; ++ai)
#pragma unroll
            for (int m = 0; m < 4; ++m) {
              __builtin_amdgcn_sched_barrier(0); const int t = brow + ai * 128 + wr * 64 + m * 16 + fr;
#pragma unroll
              for (int n = 0; n < 2; ++n) {
                const int c = n * 16 + fq * 4;
                if (c < 24) { f4 v = acc[ai][bj][m][n];
#pragma unroll
                  for (int j = 0; j < 4; ++j) v[j] = sigmoidf_(v[j]);
                  *(f4*)(NG + (size_t)t * 24 + c) = v; }
              }
            }
        }
      }
    }
  }
};

struct EpiGate {
  unsigned char* G;
  DEVI void operator()(const f4 (&acc)[2][2][4][2], int brow, int bcol, int wr, int wc, int fr, int fq) const {
#pragma unroll
    for (int ai = 0; ai < 2; ++ai)
#pragma unroll
      for (int m = 0; m < 4; ++m) {
        __builtin_amdgcn_sched_barrier(0);
        const int t = brow + ai * 128 + wr * 64 + m * 16 + fr;
#pragma unroll
        for (int bj = 0; bj < 2; ++bj)
#pragma unroll
          for (int n = 0; n < 2; ++n) {
            const f4 v = acc[ai][bj][m][n];
            unsigned w = 0u;
#pragma unroll
            for (int j = 0; j < 4; ++j) { const float gq = fminf(fmaxf(sigmoidf_(v[j]) * 255.0f + 0.5f, 1.0f), 255.0f); w |= ((unsigned)gq) << (8 * j); }
            *(unsigned*)(G + (size_t)t * 3072 + bcol + bj * 128 + wc * 32 + n * 16 + fq * 4) = w;
          }
      }
  }
};

struct EpiGlu {
  hf* Y;
  DEVI void operator()(const f4 (&acc)[2][2][4][2], int brow, int bcol, int wr, int wc, int fr, int fq) const {
#pragma unroll
    for (int ai = 0; ai < 2; ++ai)
#pragma unroll
      for (int m = 0; m < 4; ++m) {
        __builtin_amdgcn_sched_barrier(0); const int t = brow + ai * 128 + wr * 64 + m * 16 + fr;
#pragma unroll
        for (int n = 0; n < 2; ++n) {
          const f4 a = acc[ai][0][m][n], g = acc[ai][1][m][n]; f4 o;
#pragma unroll
          for (int j = 0; j < 4; ++j) o[j] = a[j] * sigmoidf_(g[j]);
          *(h4*)(Y + (size_t)t * 1536 + (bcol >> 1) + wc * 32 + n * 16 + fq * 4) = pack4(o);
        }
      }
  }
};

struct EpiSwiglu {
  hf* H;
  DEVI void operator()(const f4 (&acc)[2][2][4][2], int brow, int bcol, int wr, int wc, int fr, int fq) const {
#pragma unroll
    for (int ai = 0; ai < 2; ++ai)
#pragma unroll
      for (int m = 0; m < 4; ++m) {
        __builtin_amdgcn_sched_barrier(0); const int t = brow + ai * 128 + wr * 64 + m * 16 + fr;
        h8 o;
#pragma unroll
        for (int n = 0; n < 2; ++n) {
          const f4 g = acc[ai][0][m][n], u = acc[ai][1][m][n];
#pragma unroll
          for (int j = 0; j < 4; ++j) o[n * 4 + j] = (hf)(g[j] * sigmoidf_(g[j]) * u[j]);
        }
        *(h8*)(H + (size_t)t * FFH + (bcol >> 1) + wc * 32 + fq * 8) = o;
      }
  }
};

struct HookMerge {
  const unsigned char* G;
  DEVI void operator()(f4 (&acc)[2][2][4][2], int t, int brow, int bcol, int wr, int wc, int fr, int fq) const {
    if (t != 8 && t != 16) return;
    const int k = (t >> 3) - 1;
    asm volatile("" : "+v"(fr), "+v"(fq));
#pragma unroll
    for (int ai = 0; ai < 2; ++ai) { __builtin_amdgcn_sched_barrier(0);
#pragma unroll
      for (int m = 0; m < 4; ++m) {
        const int row = brow + ai * 128 + wr * 64 + m * 16 + fr;
#pragma unroll
        for (int bj = 0; bj < 2; ++bj)
#pragma unroll
          for (int n = 0; n < 2; ++n) {
            const int col = bcol + bj * 128 + wc * 32 + n * 16 + fq * 4;
            const unsigned wa = *(const unsigned*)(G + (size_t)row * 3072 + k * 1024 + col), wb = *(const unsigned*)(G + (size_t)row * 3072 + (k + 1) * 1024 + col);
#pragma unroll
            for (int j = 0; j < 4; ++j) acc[ai][bj][m][n][j] *= (float)((wa >> (8 * j)) & 255u) * frcp((float)((wb >> (8 * j)) & 255u));
          }
      }
    }
  }
};
struct EpiMerge {
  const unsigned char* G; hf* M;
  DEVI void operator()(const f4 (&acc)[2][2][4][2], int brow, int bcol, int wr, int wc, int fr, int fq) const {
#pragma unroll
    for (int ai = 0; ai < 2; ++ai) { __builtin_amdgcn_sched_barrier(0);
#pragma unroll
      for (int m = 0; m < 4; ++m) {
        const int row = brow + ai * 128 + wr * 64 + m * 16 + fr;
#pragma unroll
        for (int bj = 0; bj < 2; ++bj)
#pragma unroll
          for (int n = 0; n < 2; ++n) {
            const int col = bcol + bj * 128 + wc * 32 + n * 16 + fq * 4;
            const unsigned w2 = *(const unsigned*)(G + (size_t)row * 3072 + 2048 + col);
            f4 o = acc[ai][bj][m][n];
#pragma unroll
            for (int j = 0; j < 4; ++j) o[j] *= (float)((w2 >> (8 * j)) & 255u) * (1.0f / 255.0f);
            *(h4*)(M + (size_t)row * 1024 + col) = pack4(o);
          }
      }
    }
  }
};
struct EpiRes {
  const float* resf; const hf* resh; float* X; hf* XH; const float* g; const float* b; unsigned long long* xbuf; unsigned* cnt; unsigned want; char* smem;
  DEVI void operator()(f4 (&acc)[2][2][4][2], int brow, int bcol, int wr, int wc, int fr, int fq) const {
    const int pm = brow >> 8, pn = bcol >> 8;
    const int tid = otid(), wid = __builtin_amdgcn_readfirstlane(tid >> 6), lane = tid & 63;
    f2* Pt = (f2*)smem;
    f2* S = (f2*)(smem + 8192);
#pragma unroll
    for (int ai = 0; ai < 2; ++ai) { __builtin_amdgcn_sched_barrier(0);
#pragma unroll
      for (int m = 0; m < 4; ++m) {
        const int row = brow + ai * 128 + wr * 64 + m * 16 + fr;
        float s1 = 0.f, s2 = 0.f;
#pragma unroll
        for (int bj = 0; bj < 2; ++bj)
#pragma unroll
          for (int n = 0; n < 2; ++n) {
            const size_t o = (size_t)row * 1024 + bcol + bj * 128 + wc * 32 + n * 16 + fq * 4;
            f4 rv;
            if (resf) rv = *(const f4*)(resf + o); else { const h4 rh = *(const h4*)(resh + o); rv = (f4){(float)rh[0], (float)rh[1], (float)rh[2], (float)rh[3]}; }
            const f4 y = rv * ALPHA + acc[ai][bj][m][n];
            acc[ai][bj][m][n] = y;
            s1 += (y[0] + y[1]) + (y[2] + y[3]); s2 += (y[0] * y[0] + y[1] * y[1]) + (y[2] * y[2] + y[3] * y[3]);
          }
        s1 += __shfl_xor(s1, 16); s1 += __shfl_xor(s1, 32); s2 += __shfl_xor(s2, 16); s2 += __shfl_xor(s2, 32);
        if (fq == 0) Pt[(ai * 128 + wr * 64 + m * 16 + fr) * 4 + wc] = (f2){s1, s2};
      }
    }
    __syncthreads();
    if (tid < 256) {
      const f2 a = Pt[tid * 4 + 0], b2 = Pt[tid * 4 + 1], c = Pt[tid * 4 + 2], d = Pt[tid * 4 + 3];
      const float sm = (a[0] + b2[0]) + (c[0] + d[0]), sq = (a[1] + b2[1]) + (c[1] + d[1]);
      __hip_atomic_store(xbuf + ((size_t)(pm * 256 + tid) * 4 + pn), ((unsigned long long)__float_as_uint(sq) << 32) | __float_as_uint(sm), __ATOMIC_RELAXED, __HIP_MEMORY_SCOPE_AGENT);
    }
    asm volatile("s_waitcnt vmcnt(0)" ::: "memory");
    if (wid < 4 && lane == 0) __hip_atomic_fetch_add(cnt + 64 * pm, 1u, __ATOMIC_RELAXED, __HIP_MEMORY_SCOPE_AGENT);
    if (wid == 0) {
      unsigned sp = 0;
      while ((unsigned)__builtin_amdgcn_readfirstlane(__hip_atomic_load(cnt + 64 * pm, __ATOMIC_RELAXED, __HIP_MEMORY_SCOPE_AGENT)) < want) { __builtin_amdgcn_s_sleep(2); if (++sp > (1u << 22)) break; }
      __builtin_amdgcn_fence(__ATOMIC_ACQUIRE, "agent");
    }
    asm volatile("s_waitcnt vmcnt(0) lgkmcnt(0)" ::: "memory");
    __syncthreads();
    if (tid < 256) {
      const unsigned long long* slot = xbuf + (size_t)(pm * 256 + tid) * 4;
      float sm = 0.f, sq = 0.f;
#pragma unroll
      for (int t = 0; t < 4; ++t) { const unsigned long long w = __hip_atomic_load(slot + t, __ATOMIC_RELAXED, __HIP_MEMORY_SCOPE_AGENT); sm += __uint_as_float((unsigned)w); sq += __uint_as_float((unsigned)(w >> 32)); }
      const float mu = sm * (1.0f / 1024.0f), var = sq * (1.0f / 1024.0f) - mu * mu;
      S[tid] = (f2){mu, rsqrtf(var + 1e-5f)};
    }
    __syncthreads();
    f4 gg[2][2], bb[2][2];
#pragma unroll
    for (int bj = 0; bj < 2; ++bj)
#pragma unroll
      for (int n = 0; n < 2; ++n) { const int col = bcol + bj * 128 + wc * 32 + n * 16 + fq * 4; gg[bj][n] = *(const f4*)(g + col); bb[bj][n] = *(const f4*)(b + col); }
#pragma unroll
    for (int ai = 0; ai < 2; ++ai) { __builtin_amdgcn_sched_barrier(0);
#pragma unroll
      for (int m = 0; m < 4; ++m) {
        const int rl = ai * 128 + wr * 64 + m * 16 + fr;
        const f2 st = S[rl];
#pragma unroll
        for (int bj = 0; bj < 2; ++bj)
#pragma unroll
          for (int n = 0; n < 2; ++n) {
            const size_t o = (size_t)(brow + rl) * 1024 + bcol + bj * 128 + wc * 32 + n * 16 + fq * 4;
            const f4 y = (acc[ai][bj][m][n] - st[0]) * st[1] * gg[bj][n] + bb[bj][n];
            if (X) *(f4*)(X + o) = y;
            if (XH) *(h4*)(XH + o) = pack4(y);
          }
      }
    }
  }
};


DEVI void ssm_c_tile(const P& p, int l, int g, int mt, int nt, char* smem) {
  char* ws = p.ws;
  const hf* A = (const hf*)(ws + OFF_USSM) + ((size_t)g * 1024 + mt * 128) * 384;
  const hf* Bt = (const hf*)(ws + OFF_WC) + ((size_t)g * 256 + nt * 64) * 384;
  const float dt = ((const float*)(ws + OFF_CB1 + 2048))[l * 32 + g];
  const float* Dk = p.ssm_d + l * 512 + g * 16;
  hf* Y = (hf*)(ws + OFF_YGELU);
  auto af = [&](int r, int k) { return A + (size_t)r * 384 + k; };
  auto bf = [&](int n, int k) { return Bt + (size_t)n * 384 + k; };
  auto ef = [&](int r, int c0, f4 v) {
    const int R = mt * 128 + r, n = nt * 64 + c0, li = n >> 4, co = n & 15;
    const h4 u = *(const h4*)(A + (size_t)r * 384 + n);
    const f4 dd = *(const f4*)(Dk + co); f4 o;
#pragma unroll
    for (int jj = 0; jj < 4; ++jj) o[jj] = gelu_tanh(dt * v[jj] + dd[jj] * (float)u[jj]);
    *(h4*)(Y + ((size_t)R * 16 + li) * 512 + g * 16 + co) = pack4(o);
  };
  sgemm_tile<2>(384, af, bf, ef, smem);
}

DEVI void ssm_ab(const P& p, int l, int g, int b, char* smem) {
  char* ws = p.ws;
  float* SPL = (float*)(smem + 65536);
  const hf* A = (const hf*)(ws + OFF_USSM) + ((size_t)g * 1024 + b * 128) * 384;
  for (int nt = 0; nt < 2; ++nt) {
    const hf* Bt = (const hf*)(ws + OFF_W1) + ((size_t)g * 128 + nt * 64) * 256;
    auto af = [&](int r, int k) { return A + (size_t)r * 384 + k; };
    auto bf = [&](int n, int k) { return Bt + (size_t)n * 256 + k; };
    auto ef = [&](int r, int c0, f4 v) { *(f4*)(SPL + r * 128 + nt * 64 + c0) = v; };
    sgemm_tile<2>(256, af, bf, ef, smem);
  }
  __syncthreads();
  {
    const int tid = otid(), pp = tid & 63, seg = __builtin_amdgcn_readfirstlane(tid >> 6), c0 = seg * 16;
    const f2 lam = *(const f2*)((const float*)(ws + OFF_LAM16) + (g * 64 + pp) * 2);
    float lr[16], li[16];
    float hr = 0.f, hi = 0.f;
#pragma unroll
    for (int i = 0; i < 16; ++i) {
      lr[i] = hr; li[i] = hi;
      const float sr = SPL[(c0 + i) * 128 + pp], si = SPL[(c0 + i) * 128 + 64 + pp];
      const float nr = lam[0] * hr - lam[1] * hi + sr, ni = lam[0] * hi + lam[1] * hr + si;
      hr = nr; hi = ni;
    }
    f2* E = (f2*)smem;
    E[seg * 64 + pp] = (f2){hr, hi};
    float qr = lam[0], qi = lam[1];
#pragma unroll
    for (int s = 0; s < 4; ++s) { const float tr = qr * qr - qi * qi, ti = 2.f * qr * qi; qr = tr; qi = ti; }
    __syncthreads();
    float Hr = 0.f, Hi = 0.f;
    for (int s = 0; s < seg; ++s) { const f2 e = E[s * 64 + pp]; const float tr = qr * Hr - qi * Hi + e[0], ti = qr * Hi + qi * Hr + e[1]; Hr = tr; Hi = ti; }
    hf* U = (hf*)(ws + OFF_USSM) + ((size_t)g * 1024 + b * 128 + c0) * 384;
    float pr = 1.f, pi = 0.f;
#pragma unroll
    for (int i = 0; i < 16; ++i) {
      const float outr = lr[i] + pr * Hr - pi * Hi, outi = li[i] + pr * Hi + pi * Hr;
      U[(size_t)i * 384 + 256 + pp] = (hf)outr; U[(size_t)i * 384 + 320 + pp] = (hf)outi;
      const float tr = pr * lam[0] - pi * lam[1], ti = pr * lam[1] + pi * lam[0]; pr = tr; pi = ti;
    }
  }
  __syncthreads();
}

DEVI void phase_2(const P& p, int l, char* smem) {
  char* ws = p.ws;
  const int G = gridDim.x;
  for (int it = obid(); it < 256; it += G) {
    const int nt = it & 3, mt = (it >> 2) & 15, jh = it >> 6, j = jh >> 1, h = jh & 1;
    const hf* src = (const hf*)(ws + OFF_KV + (size_t)j * SZ_KV1) + (size_t)h * T_ * 64;
    const hf* Bt = (const hf*)(ws + OFF_BTC1) + ((size_t)j * 256 + nt * 64) * 2048;
    const float* cb = (const float*)(ws + OFF_CB1) + j * 256 + nt * 64;
    hf* HG = (hf*)(ws + OFF_HG) + ((size_t)jh * 1024 + mt * 64) * 256 + nt * 64;
    auto af = [&](int r, int k) { const int R = mt * 64 + r, b = R >> 7, n = min(R & 127, 126); return src + ((size_t)b * 2048 + 16 * n) * 64 + k; };
    auto bf = [&](int n, int k) { return Bt + (size_t)n * 2048 + k; };
    auto ef = [&](int r, int c0, f4 v) { const f4 bb = *(const f4*)(cb + c0); f4 o;
#pragma unroll
      for (int jj = 0; jj < 4; ++jj) o[jj] = gelu_tanh(v[jj] + bb[jj]);
      *(h4*)(HG + (size_t)r * 256 + c0) = pack4(o); };
    sgemm_tile<1>(2048, af, bf, ef, smem);
  }
  for (int it = obid(); it < 256; it += G) ssm_ab(p, l, it >> 3, it & 7, smem);
  {
    const hf* U = (const hf*)(ws + OFF_UPOOL); hf* PO = (hf*)(ws + OFF_POOLED);
    const int gtid = obid() * 512 + otid(), gnt = G * 512;
    for (int idx = gtid; idx < T_ * 64; idx += gnt) {
      const int c8 = idx & 63, t = idx >> 6, s = t & (S_ - 1), gi = c8 >> 4, w = 2 << gi;
      const int cnt = min(w, s + 1);
      float sum[8];
#pragma unroll
      for (int i = 0; i < 8; ++i) sum[i] = 0.f;
      for (int q = 0; q < cnt; ++q) { const h8 v = *(const h8*)(U + (size_t)(t - q) * 512 + c8 * 8);
#pragma unroll
        for (int i = 0; i < 8; ++i) sum[i] += (float)v[i]; }
      const h8 cur = *(const h8*)(U + (size_t)t * 512 + c8 * 8);
      const float inv = 1.0f / (float)cnt;
      h8 o;
#pragma unroll
      for (int i = 0; i < 8; ++i) o[i] = (hf)(sum[i] * inv - (float)cur[i]);
      *(h8*)(PO + (size_t)t * 512 + c8 * 8) = o;
    }
  }
}

DEVI void phase_3(const P& p, int l, char* smem) {
  char* ws = p.ws;
  const int G = gridDim.x;
  for (int it = obid(); it < 1024; it += G) ssm_c_tile(p, l, it >> 5, (it >> 2) & 7, it & 3, smem);
  for (int it = G - 1 - obid(); it < 32; it += G) {
    const int mt = it & 7, jh = it >> 3, j = jh >> 1, h = jh & 1;
    const hf* A = (const hf*)(ws + OFF_HG) + ((size_t)jh * 1024 + mt * 128) * 256;
    const hf* Bt = (const hf*)(ws + OFF_BTC2) + (size_t)j * 64 * 256;
    hf* KC = (hf*)(ws + OFF_KCOMP);
    auto af = [&](int r, int k) { return A + (size_t)r * 256 + k; };
    auto bf = [&](int n, int k) { return Bt + (size_t)n * 256 + k; };
    auto ef = [&](int r, int c0, f4 v) { const int R = mt * 128 + r, b = R >> 7, n = R & 127; *(h4*)(KC + ((((size_t)j * 8 + b) * 2 + h) * 128 + n) * 64 + c0) = pack4(v); };
    sgemm_tile<2>(256, af, bf, ef, smem);
  }
  for (int it = obid(); it < 1024; it += G) {
    const int nt = it & 1, gi = (it >> 1) & 3, mt = it >> 3;
    const hf* A = (const hf*)(ws + OFF_POOLED) + (size_t)mt * 128 * 512 + gi * 128;
    const hf* Bt = (const hf*)(ws + OFF_BTPOOL) + ((size_t)gi * 128 + nt * 64) * 128;
    const float* sc = p.pool_scale + l * 512 + gi * 128 + nt * 64;
    hf* Y = (hf*)(ws + OFF_YBR) + (size_t)mt * 128 * 1536 + 512 + gi * 128 + nt * 64;
    auto af = [&](int r, int k) { return A + (size_t)r * 512 + k; };
    auto bf = [&](int n, int k) { return Bt + (size_t)n * 128 + k; };
    auto ef = [&](int r, int c0, f4 v) { const f4 s4 = *(const f4*)(sc + c0); *(h4*)(Y + (size_t)r * 1536 + c0) = pack4(v * s4); };
    sgemm_tile<2>(128, af, bf, ef, smem);
  }
}


DEVI int crow16(int i, int hh) { return (i & 3) + 8 * (i >> 2) + 4 * hh; }
constexpr float LOG2E = 1.4426950408889634f;

struct NsaCtx {
  hf* Kb; hf* Vb; int tid, w, lane, l32, hh;
  h8 qf[4];
};
DEVI void nsa_stage_load(const NsaCtx& c, const hf* kt, const hf* vt, h8& kr, h8& vr) {
  kr = *(const h8*)(kt + (c.tid >> 3) * 64 + (c.tid & 7) * 8);
  vr = *(const h8*)(vt + c.lane * 64 + c.w * 8);
}
DEVI void nsa_stage_store(const NsaCtx& c, int buf, const h8& kr, const h8& vr) {
  *(h8*)(c.Kb + buf * 4608 + (c.tid >> 3) * 72 + (c.tid & 7) * 8) = kr;
#pragma unroll
  for (int i = 0; i < 8; ++i) c.Vb[buf * 4608 + (c.w * 8 + i) * 68 + c.lane] = vr[i];
}
DEVI void nsa_compute_s(const NsaCtx& c, int buf, f16v (&s)[2]) {
#pragma unroll
  for (int kt = 0; kt < 2; ++kt) {
#pragma unroll
    for (int i = 0; i < 16; ++i) s[kt][i] = 0.f;
#pragma unroll
    for (int st = 0; st < 4; ++st) {
      const h8 a = *(const h8*)(c.Kb + buf * 4608 + (kt * 32 + c.l32) * 72 + st * 16 + c.hh * 8);
      s[kt] = __builtin_amdgcn_mfma_f32_32x32x16_f16(a, c.qf[st], s[kt], 0, 0, 0);
    }
  }
}
DEVI void nsa_compute_pv(const NsaCtx& c, int buf, const f16v (&pr)[2], f16v (&o)[2]) {
#pragma unroll
  for (int kt = 0; kt < 2; ++kt)
#pragma unroll
    for (int s2 = 0; s2 < 2; ++s2) {
      h8 pb;
#pragma unroll
      for (int j = 0; j < 8; ++j) pb[j] = (hf)pr[kt][8 * s2 + j];
#pragma unroll
      for (int dt = 0; dt < 2; ++dt) {
        const hf* vrow = c.Vb + buf * 4608 + (dt * 32 + c.l32) * 68 + kt * 32 + s2 * 16 + c.hh * 4;
        const h4 lo = *(const h4*)vrow, hi = *(const h4*)(vrow + 8);
        h8 a; a[0] = lo[0]; a[1] = lo[1]; a[2] = lo[2]; a[3] = lo[3]; a[4] = hi[0]; a[5] = hi[1]; a[6] = hi[2]; a[7] = hi[3];
        o[dt] = __builtin_amdgcn_mfma_f32_32x32x16_f16(a, pb, o[dt], 0, 0, 0);
      }
    }
}

template <int MODE>
DEVI void nsa_run(const NsaCtx& c, unsigned tiles, const hf* Kbase, const hf* Vbase, int t, int qb, unsigned selmask, f16v (&o)[2], float& m, float& l) {
  h8 kr, vr;
  int j = __builtin_ctz(tiles); tiles &= tiles - 1;
  nsa_stage_load(c, Kbase + (size_t)j * 4096, Vbase + (size_t)j * 4096, kr, vr);
  __syncthreads();
  nsa_stage_store(c, 0, kr, vr);
  __syncthreads();
  int buf = 0;
  while (true) {
    const bool more = tiles != 0u;
    int jn = 0;
    if (more) { jn = __builtin_ctz(tiles); tiles &= tiles - 1; nsa_stage_load(c, Kbase + (size_t)jn * 4096, Vbase + (size_t)jn * 4096, kr, vr); }
    bool tile_ok = true;
    if (MODE == 1) tile_ok = (selmask >> j) & 1u;
    if (MODE != 1 || __builtin_amdgcn_ballot_w64(tile_ok) != 0ull) {
    f16v s[2];
    nsa_compute_s(c, buf, s);
    const bool edge = (j == qb) || (MODE == 2 && j == qb - 8);
    float mx = -1e30f;
    if (edge) {
#pragma unroll
      for (int kt = 0; kt < 2; ++kt)
#pragma unroll
        for (int i = 0; i < 16; ++i) {
          const int key = j * 64 + kt * 32 + crow16(i, c.hh);
          bool ok = tile_ok && key <= t;
          if (MODE == 2) ok = ok && (t - key < 512);
          const float v = ok ? s[kt][i] : -1e30f;
          s[kt][i] = v; mx = fmaxf(mx, v);
        }
    } else {
#pragma unroll
      for (int kt = 0; kt < 2; ++kt)
#pragma unroll
        for (int i = 0; i < 16; ++i) {
          const float v = (MODE == 2 || tile_ok) ? s[kt][i] : -1e30f;
          s[kt][i] = v; mx = fmaxf(mx, v);
        }
    }
    mx = fmaxf(mx, __shfl_xor(mx, 32));
    const float mn = fmaxf(m, mx), corr = __builtin_amdgcn_exp2f(m - mn);
    m = mn;
    float ls = 0.f;
    if (!edge && (MODE == 2 || j > 0)) {
#pragma unroll
      for (int kt = 0; kt < 2; ++kt)
#pragma unroll
        for (int i = 0; i < 16; ++i) { const float pv = __builtin_amdgcn_exp2f(s[kt][i] - mn); s[kt][i] = pv; ls += pv; }
    } else {
#pragma unroll
      for (int kt = 0; kt < 2; ++kt)
#pragma unroll
        for (int i = 0; i < 16; ++i) { const float pv = s[kt][i] > -1e29f ? __builtin_amdgcn_exp2f(s[kt][i] - mn) : 0.f; s[kt][i] = pv; ls += pv; }
    }
    l = l * corr + ls;
    if (__builtin_amdgcn_ballot_w64(corr != 1.0f) != 0ull) {
#pragma unroll
      for (int dt = 0; dt < 2; ++dt)
#pragma unroll
        for (int i = 0; i < 16; ++i) o[dt][i] *= corr;
    }
    nsa_compute_pv(c, buf, s, o);
    }
    if (more) nsa_stage_store(c, buf ^ 1, kr, vr);
    __syncthreads();
    if (!more) break;
    buf ^= 1; j = jn;
  }
}

DEVI void nsa_item(const P& p, int b, int hkv, int qb, char* smem) {
  char* ws = p.ws;
  NsaCtx c;
  c.Kb = (hf*)smem; c.Vb = (hf*)(smem + 2 * 9216);
  unsigned* maskw = (unsigned*)(smem + 36864);
  float* score = (float*)(smem + 36864 + 256);
  float* impP = (float*)(smem + 36864 + 256 + 8448);
  c.tid = otid(); c.w = __builtin_amdgcn_readfirstlane(c.tid >> 6); c.lane = c.tid & 63; c.l32 = c.lane & 31; c.hh = c.lane >> 5;
  const int g = c.w >> 1, half = c.w & 1, tl = half * 32 + c.l32, t = qb * 64 + tl, tg = b * S_ + t, head = hkv * 4 + g;
  {
    const hf* Qp = (const hf*)(ws + OFF_Q) + (size_t)tg * 512 + head * 64 + c.hh * 8;
#pragma unroll
    for (int st = 0; st < 4; ++st) { h8 q = *(const h8*)(Qp + st * 16);
#pragma unroll
      for (int i = 0; i < 8; ++i) q[i] = (hf)((float)q[i] * (0.125f * LOG2E));
      c.qf[st] = q; }
  }
  const float* NG = (const float*)(ws + OFF_NSAG) + (size_t)tg * 24;
  const float g_cmp = NG[head], g_sel = NG[8 + head], g_win = NG[16 + head];
  f16v fin[2];
  {
    const hf* Kc = (const hf*)(ws + OFF_KCOMP) + (((size_t)0 * 8 + b) * 2 + hkv) * 128 * 64;
    const hf* Vc = (const hf*)(ws + OFF_KCOMP) + (((size_t)1 * 8 + b) * 2 + hkv) * 128 * 64;
    h8 kr, vr, kr1, vr1;
    nsa_stage_load(c, Kc, Vc, kr, vr); nsa_stage_load(c, Kc + 4096, Vc + 4096, kr1, vr1);
    __syncthreads();
    nsa_stage_store(c, 0, kr, vr); nsa_stage_store(c, 1, kr1, vr1);
    __syncthreads();
    f16v s0[2], s1[2];
    nsa_compute_s(c, 0, s0); nsa_compute_s(c, 1, s1);
    float mx = -1e30f;
#pragma unroll
    for (int kt = 0; kt < 2; ++kt)
#pragma unroll
      for (int i = 0; i < 16; ++i) {
        const int n0 = kt * 32 + crow16(i, c.hh), n1 = 64 + n0;
        const float v0 = (16 * n0 + 31 <= t) ? s0[kt][i] : -1e30f, v1 = (16 * n1 + 31 <= t) ? s1[kt][i] : -1e30f;
        s0[kt][i] = v0; s1[kt][i] = v1; mx = fmaxf(mx, fmaxf(v0, v1));
      }
    mx = fmaxf(mx, __shfl_xor(mx, 32));
    float ls = 0.f;
#pragma unroll
    for (int kt = 0; kt < 2; ++kt)
#pragma unroll
      for (int i = 0; i < 16; ++i) {
        const float p0 = s0[kt][i] > -1e29f ? __builtin_amdgcn_exp2f(s0[kt][i] - mx) : 0.f, p1 = s1[kt][i] > -1e29f ? __builtin_amdgcn_exp2f(s1[kt][i] - mx) : 0.f;
        s0[kt][i] = p0; s1[kt][i] = p1; ls += p0 + p1;
      }
    ls += __shfl_xor(ls, 32);
    const float inv = ls > 0.f ? 1.0f / ls : 0.f;
#pragma unroll
    for (int kt = 0; kt < 2; ++kt)
#pragma unroll
      for (int i = 0; i < 16; ++i) { s0[kt][i] *= inv; s1[kt][i] *= inv; }
    float* ip = impP + (g * 64 + tl) * 33;
#pragma unroll
    for (int kt = 0; kt < 2; ++kt)
#pragma unroll
      for (int q = 0; q < 4; ++q) {
        const int j0 = kt * 8 + q * 2 + c.hh;
        ip[j0] = s0[kt][4 * q] + s0[kt][4 * q + 1] + s0[kt][4 * q + 2] + 0.5f * s0[kt][4 * q + 3];
        ip[16 + j0] = s1[kt][4 * q] + s1[kt][4 * q + 1] + s1[kt][4 * q + 2] + 0.5f * s1[kt][4 * q + 3];
      }
    __syncthreads();
#pragma unroll
    for (int kt = 0; kt < 2; ++kt)
#pragma unroll
      for (int q = 0; q < 4; ++q) {
        const int j0 = kt * 8 + q * 2 + c.hh;
        ip[j0 + 1] += 0.5f * s0[kt][4 * q + 3];
        if (16 + j0 + 1 < 32) ip[16 + j0 + 1] += 0.5f * s1[kt][4 * q + 3];
      }
#pragma unroll
    for (int dt = 0; dt < 2; ++dt)
#pragma unroll
      for (int i = 0; i < 16; ++i) fin[dt][i] = 0.f;
    nsa_compute_pv(c, 0, s0, fin); nsa_compute_pv(c, 1, s1, fin);
#pragma unroll
    for (int dt = 0; dt < 2; ++dt)
#pragma unroll
      for (int i = 0; i < 16; ++i) fin[dt][i] *= g_cmp;
    __syncthreads();
  }
  for (int idx = c.tid; idx < 2048; idx += 512) {
    const int tok = idx >> 5, j = idx & 31;
    const float imp = ((impP[(0 * 64 + tok) * 33 + j] + impP[(1 * 64 + tok) * 33 + j]) + impP[(2 * 64 + tok) * 33 + j]) + impP[(3 * 64 + tok) * 33 + j];
    const bool forced = (j == 0) || (j == qb) || (j == qb - 1);
    score[tok * 33 + j] = forced ? 1e30f : (j <= qb ? imp : -1e30f);
  }
  if (c.tid < 64) maskw[c.tid] = 0u;
  __syncthreads();
  for (int idx = c.tid; idx < 2048; idx += 512) {
    const int tok = idx >> 5, j = idx & 31;
    const float sj = score[tok * 33 + j];
    int rank = 0;
    for (int jj = 0; jj < 32; ++jj) { const float o = score[tok * 33 + jj]; rank += (o > sj || (o == sj && jj < j)) ? 1 : 0; }
    if (rank < 16 && sj > -1e29f) atomicOr(&maskw[tok], 1u << j);
  }
  __syncthreads();
  const unsigned selmask = maskw[tl];
  unsigned anym = 0u;
  for (int i = 0; i < 64; ++i) anym |= maskw[i];
  {
    f16v o[2];
#pragma unroll
    for (int dt = 0; dt < 2; ++dt)
#pragma unroll
      for (int i = 0; i < 16; ++i) o[dt][i] = 0.f;
    float m = -1e30f, l = 0.f;
    const hf* Kb = (const hf*)(ws + OFF_KV + 2 * SZ_KV1) + ((size_t)hkv * T_ + (size_t)b * S_) * 64;
    const hf* Vb = (const hf*)(ws + OFF_KV + 3 * SZ_KV1) + ((size_t)hkv * T_ + (size_t)b * S_) * 64;
    nsa_run<1>(c, anym, Kb, Vb, t, qb, selmask, o, m, l);
    l += __shfl_xor(l, 32);
    const float sc = l > 0.f ? g_sel / l : 0.f;
#pragma unroll
    for (int dt = 0; dt < 2; ++dt)
#pragma unroll
      for (int i = 0; i < 16; ++i) fin[dt][i] += o[dt][i] * sc;
  }
  {
    f16v o[2];
#pragma unroll
    for (int dt = 0; dt < 2; ++dt)
#pragma unroll
      for (int i = 0; i < 16; ++i) o[dt][i] = 0.f;
    float m = -1e30f, l = 0.f;
    const hf* Kb = (const hf*)(ws + OFF_KV + 4 * SZ_KV1) + ((size_t)hkv * T_ + (size_t)b * S_) * 64;
    const hf* Vb = (const hf*)(ws + OFF_KV + 5 * SZ_KV1) + ((size_t)hkv * T_ + (size_t)b * S_) * 64;
    const int jlo = max(qb - 8, 0);
    const unsigned tiles = (unsigned)((((unsigned long long)2 << qb) - 1ull) & ~((1ull << jlo) - 1ull));
    nsa_run<2>(c, tiles, Kb, Vb, t, qb, 0u, o, m, l);
    l += __shfl_xor(l, 32);
    const float sc = l > 0.f ? g_win / l : 0.f;
#pragma unroll
    for (int dt = 0; dt < 2; ++dt)
#pragma unroll
      for (int i = 0; i < 16; ++i) fin[dt][i] += o[dt][i] * sc;
  }
  hf* Y = (hf*)(ws + OFF_YBR) + (size_t)tg * 1536 + 1024 + head * 64;
#pragma unroll
  for (int dt = 0; dt < 2; ++dt)
#pragma unroll
    for (int q = 0; q < 4; ++q) {
      h4 ov; ov[0] = (hf)fin[dt][4 * q]; ov[1] = (hf)fin[dt][4 * q + 1]; ov[2] = (hf)fin[dt][4 * q + 2]; ov[3] = (hf)fin[dt][4 * q + 3];
      *(h4*)(Y + dt * 32 + q * 8 + c.hh * 4) = ov;
    }
}

DEVI void phase_4(const P& p, int l, char* smem) {
  for (int pi = obid(); pi < 256; pi += gridDim.x) {
    const int xj = pi & 7, rr = pi >> 3, bh = 2 * xj + (rr >> 4), x = rr & 15, b = bh >> 1, hkv = bh & 1;
#pragma unroll 1
    for (int k = 0; k < 2; ++k) nsa_item(p, b, hkv, k ? x : 31 - x, smem);
  }
}

#ifndef REPW
#define REPW 1
#endif
#ifndef REP1
#define REP1 1
#endif
#ifndef REP2
#define REP2 1
#endif
#ifndef REP3
#define REP3 1
#endif
#ifndef REP4
#define REP4 1
#endif
#ifndef REP5
#define REP5 1
#endif
#ifndef REP6
#define REP6 1
#endif
#ifndef REP9
#define REP9 1
#endif
#ifndef XSYNC
#define XSYNC 0
#endif
DEVI const P& getp() {
  const __attribute__((address_space(4))) char* k = (const __attribute__((address_space(4))) char*)__builtin_amdgcn_kernarg_segment_ptr();
  asm volatile("" : "+s"(k));
  return *(const P*)k;
}
__global__ void __launch_bounds__(512) mega(P p_unused) {
  cg::grid_group grid = cg::this_grid();
  __shared__ __attribute__((aligned(16))) char smem[131072];
  __shared__ uint4 xb_words;
  if (threadIdx.x == 0) xb_words = make_uint4(0u, 0u, 0u, 0u);
  __syncthreads();
  (void)xcd_barrier_post((unsigned*)(getp().ws + OFF_BAR), (volatile LAS unsigned*)&xb_words);
#define GSYNC() do { XcdBarrier xb_; xb_.bar = (unsigned*)(getp().ws + OFF_BAR); xb_.x = xb_xcc_id(); xb_.st = (volatile LAS unsigned*)&xb_words; xcd_barrier(xb_); } while (0)
  phase_0(getp());
  grid.sync();
  for (int r = 0; r < XSYNC; ++r) GSYNC();
#pragma unroll 1
  for (int ll = 0; ll < DEPTH_; ++ll) {
    int l = ll; asm volatile("" : "+s"(l));
    if (l == 0) { phase_w(getp(), 0, smem); GSYNC(); }
    { const P& p = getp(); EpiIn e{p.ws}; for (int r = 0; r < REP1; ++r) { gemm256((const hf*)(p.ws + OFF_XH), 1024, (const hf*)(p.ws + OFF_BTIN), 1024, 1024, 64, 10, smem, e, NoHook()); GSYNC(); } }
    phase_2(getp(), l, smem);
    w_ffo(getp(), l, smem);
    GSYNC();
    for (int r = 0; r < REP3; ++r) { phase_3(getp(), l, smem); GSYNC(); }
    phase_4(getp(), l, smem);
    { const P& p = getp(); EpiGlu e{(hf*)(p.ws + OFF_YBR)}; gemm256((const hf*)(p.ws + OFF_YGELU), 512, (const hf*)(p.ws + OFF_BTGLU), 512, 512, 64, 4, smem, e, NoHook()); }
    { const P& p = getp(); EpiGate e{(unsigned char*)(p.ws + OFF_BRG)}; gemm256((const hf*)(p.ws + OFF_XH), 1024, (const hf*)(p.ws + OFF_BTIN) + NINA * 1024, 1024, 1024, 64, 12, smem, e, NoHook()); }
    GSYNC();
    { const P& p = getp(); HookMerge h{(const unsigned char*)(p.ws + OFF_BRG)}; EpiMerge e{(const unsigned char*)(p.ws + OFF_BRG), (hf*)(p.ws + OFF_MERGED)};
      for (int r = 0; r < REP6; ++r) { gemm256((const hf*)(p.ws + OFF_YBR), 1536, (const hf*)(p.ws + OFF_BTBR), 1536, 1536, 64, 4, smem, e, h); GSYNC(); } }
    { const P& p = getp(); EpiRes e{nullptr, (const hf*)(p.ws + OFF_XH), nullptr, (hf*)(p.ws + OFF_XH), p.ln_g + (l * 2 + 0) * 1024, p.ln_b + (l * 2 + 0) * 1024,
                                   (unsigned long long*)(p.ws + OFF_XS), (unsigned*)(p.ws + OFF_BAR + 16384), 16u * (unsigned)(2 * l + 1), smem};
      gemm256((const hf*)(p.ws + OFF_MERGED), 1024, (const hf*)(p.ws + OFF_BTWO), 1024, 1024, 64, 4, smem, e, NoHook()); }
    GSYNC();
    { const P& p = getp(); EpiSwiglu e{(hf*)(p.ws + OFF_HFF)}; for (int r = 0; r < REP9; ++r) { gemm256((const hf*)(p.ws + OFF_XH), 1024, (const hf*)(p.ws + OFF_BTFI), 1024, 1024, 64, 22, smem, e, NoHook()); GSYNC(); } }
    { const P& p = getp(); EpiRes e{nullptr, (const hf*)(p.ws + OFF_XH), l == DEPTH_ - 1 ? p.out : nullptr, l == DEPTH_ - 1 ? nullptr : (hf*)(p.ws + OFF_XH), p.ln_g + (l * 2 + 1) * 1024, p.ln_b + (l * 2 + 1) * 1024,
                                   (unsigned long long*)(p.ws + OFF_XS), (unsigned*)(p.ws + OFF_BAR + 16384), 16u * (unsigned)(2 * l + 2), smem};
      gemm256((const hf*)(p.ws + OFF_HFF), FFH, (const hf*)(p.ws + OFF_BTFO), FFH, FFH, 64, 4, smem, e, NoHook()); }
    if (l + 1 < DEPTH_) phase_w(getp(), l + 1, smem);
    GSYNC();
  }
}

extern "C" void kernel_launch(void* const* d_in, const int* in_sizes, int n_in, void* d_out, int out_size, void* d_ws, size_t ws_size, hipStream_t stream) {
  static int grid_blocks = 0;
  if (!grid_blocks) {
    int dev = 0, cus = 0, per = 0;
    hipGetDevice(&dev);
    hipDeviceGetAttribute(&cus, hipDeviceAttributeMultiprocessorCount, dev);
    hipOccupancyMaxActiveBlocksPerMultiprocessor(&per, mega, 512, 0);
    if (per < 1) per = 1;
    if (per > 1) per = 1;
    grid_blocks = cus * per;
  }
  P p{};
  p.x = (const float*)d_in[0]; p.pos = (const int*)d_in[1]; p.w_in = (const float*)d_in[2]; p.a_re = (const float*)d_in[3]; p.a_im = (const float*)d_in[4];
  p.log_dt = (const float*)d_in[5]; p.b_re = (const float*)d_in[6]; p.b_im = (const float*)d_in[7]; p.c_re = (const float*)d_in[8]; p.c_im = (const float*)d_in[9];
  p.ssm_d = (const float*)d_in[10]; p.w_glu = (const float*)d_in[11]; p.pool_w = (const float*)d_in[12]; p.pool_scale = (const float*)d_in[13];
  p.cmp_pos = (const float*)d_in[14]; p.cmp_w1 = (const float*)d_in[15]; p.cmp_b1 = (const float*)d_in[16]; p.cmp_w2 = (const float*)d_in[17];
  p.w_branch = (const float*)d_in[18]; p.w_out = (const float*)d_in[19]; p.ln_g = (const float*)d_in[20]; p.ln_b = (const float*)d_in[21];
  p.ffn_w_in = (const float*)d_in[22]; p.ffn_w_out = (const float*)d_in[23];
  p.out = (float*)d_out; p.ws = (char*)d_ws;
  hipMemsetAsync((char*)d_ws + OFF_BAR, 0, 32768, stream);
  void* args[] = {&p};
  hipError_t e = hipLaunchCooperativeKernel((void*)mega, dim3(grid_blocks), dim3(512), args, 0, stream);
  if (e != hipSuccess) fprintf(stderr, "cooperative launch failed: %s (grid %d)\n", hipGetErrorString(e), grid_blocks);
}
```

```cpp
#include <hip/hip_runtime.h>
#include <hip/hip_cooperative_groups.h>
#include <cstdio>
namespace cg = cooperative_groups;

typedef _Float16 hf;
typedef _Float16 h8 __attribute__((ext_vector_type(8)));
typedef _Float16 h4 __attribute__((ext_vector_type(4)));
typedef float f4 __attribute__((ext_vector_type(4)));
typedef float f2 __attribute__((ext_vector_type(2)));
typedef float f16v __attribute__((ext_vector_type(16)));
#define DEVI __device__ __forceinline__
DEVI int otid() { int t = threadIdx.x; asm volatile("" : "+v"(t)); return t; }
DEVI int obid() { int b = blockIdx.x; asm volatile("" : "+s"(b)); return b; }

constexpr int T_ = 16384, S_ = 2048, DEPTH_ = 4;
constexpr int NIN = 5632;
constexpr int FFH = 2816;
constexpr float ALPHA = 1.6817928305074290f;

constexpr size_t OFF_BTIN = 0;
constexpr size_t OFF_BTFI = OFF_BTIN + (size_t)NIN * 1024 * 2;
constexpr size_t OFF_BTFO = OFF_BTFI + (size_t)NIN * 1024 * 2;
constexpr size_t OFF_BTWO = OFF_BTFO + (size_t)1024 * FFH * 2;
constexpr size_t OFF_BTBR = OFF_BTWO + (size_t)1024 * 1024 * 2;
constexpr size_t OFF_BTGLU = OFF_BTBR + (size_t)1024 * 1536 * 2;
constexpr size_t OFF_BTC1 = OFF_BTGLU + (size_t)1024 * 512 * 2;
constexpr size_t OFF_BTC2 = OFF_BTC1 + (size_t)2 * 256 * 2048 * 2;
constexpr size_t OFF_BTPOOL = OFF_BTC2 + (size_t)2 * 64 * 256 * 2;
constexpr size_t OFF_WC = OFF_BTPOOL + (size_t)4 * 128 * 128 * 2;
constexpr size_t OFF_W1 = OFF_WC + (size_t)32 * 256 * 384 * 2;
constexpr size_t OFF_LAM16 = OFF_W1 + (size_t)32 * 128 * 256 * 2;
constexpr size_t OFF_CB1 = OFF_LAM16 + (size_t)32 * 64 * 8;
constexpr size_t OFF_ROPE = OFF_CB1 + 4096;
constexpr size_t OFF_XH = OFF_ROPE + (size_t)T_ * 32 * 8;
constexpr size_t OFF_SP = OFF_XH;

constexpr size_t OFF_BRG = OFF_XH + (size_t)T_ * 1024 * 2;
constexpr size_t OFF_HFF = OFF_BRG;
constexpr size_t OFF_YBR = OFF_BRG + (size_t)T_ * 3072 * 2;
constexpr size_t OFF_USSM = OFF_YBR + (size_t)T_ * 1536 * 2;
constexpr size_t OFF_UPOOL = OFF_USSM + (size_t)32 * 1024 * 384 * 2;
constexpr size_t OFF_YGELU = OFF_UPOOL;
constexpr size_t OFF_Q = OFF_UPOOL + (size_t)T_ * 512 * 2;
constexpr size_t OFF_KV = OFF_Q + (size_t)T_ * 512 * 2;
constexpr size_t SZ_KV1 = (size_t)2 * T_ * 64 * 2;
constexpr size_t OFF_NSAG = OFF_KV + 6 * SZ_KV1 + 65536;
constexpr size_t OFF_HG = OFF_NSAG + (size_t)T_ * 24 * 4;
constexpr size_t OFF_KCOMP = OFF_HG + (size_t)4 * 1024 * 256 * 2;
constexpr size_t OFF_ETAB = OFF_KCOMP + (size_t)2 * 8 * 2 * 128 * 64 * 2;
constexpr size_t OFF_BAR = OFF_ETAB + (size_t)DEPTH_ * 2048 * 18 * 8;
constexpr size_t OFF_XS = OFF_BAR + 32768;
constexpr size_t OFF_POOLED = OFF_XS + (size_t)64 * 256 * 4 * 8;
constexpr size_t OFF_MERGED = OFF_Q;
constexpr size_t NINA = 2560, NINB = 3072;
constexpr size_t WS_TOTAL = OFF_POOLED + (size_t)T_ * 512 * 2;
static_assert(WS_TOTAL < (size_t)352 * 1024 * 1024, "workspace too large");

struct P {
  const float* x; const int* pos; const float* w_in; const float* a_re; const float* a_im; const float* log_dt;
  const float* b_re; const float* b_im; const float* c_re; const float* c_im; const float* ssm_d; const float* w_glu;
  const float* pool_w; const float* pool_scale; const float* cmp_pos; const float* cmp_w1; const float* cmp_b1; const float* cmp_w2;
  const float* w_branch; const float* w_out; const float* ln_g; const float* ln_b; const float* ffn_w_in; const float* ffn_w_out;
  float* out; char* ws;
};

DEVI float frcp(float x) { return __builtin_amdgcn_rcpf(x); }
DEVI float sigmoidf_(float x) { return frcp(1.0f + __expf(-x)); }
DEVI float gelu_tanh(float x) { const float u = 0.7978845608028654f * (x + 0.044715f * x * x * x); return x * frcp(1.0f + __expf(-2.0f * u)); }
DEVI h4 pack4(f4 v) { h4 r; r[0] = (hf)v[0]; r[1] = (hf)v[1]; r[2] = (hf)v[2]; r[3] = (hf)v[3]; return r; }


#define XB_TMO      128
#define XB_XCNT(j)  (256  + 64 * (j))
#define XB_XSUB(j)  (1280 + 64 * (j))
#define XB_XGEN(j)  (2304 + 64 * (j))
#define XB_TOP      3328
#define XB_TOPGEN   3392
#define XCD_BAR_WORDS 3456
#define XB_SPIN_CAP (1u << 20)
#define LAS __attribute__((address_space(3)))
DEVI unsigned xb_ld(unsigned* p)              { return __hip_atomic_load(p, __ATOMIC_RELAXED, __HIP_MEMORY_SCOPE_AGENT); }
DEVI unsigned xb_add(unsigned* p, unsigned v) { return __hip_atomic_fetch_add(p, v, __ATOMIC_RELAXED, __HIP_MEMORY_SCOPE_AGENT); }
DEVI unsigned xb_xcc_id() { return (unsigned)__builtin_amdgcn_s_getreg((3 << 11) | 20) & 0xFu; }
#define XB_SPIN(cond, bar) do { unsigned _sp = 0; while (cond) { __builtin_amdgcn_s_sleep(1); \
    if ((++_sp & 255u) == 0u) { if (xb_ld(&(bar)[XB_TMO])) break; if (_sp > XB_SPIN_CAP) { atomicAdd(&(bar)[XB_TMO], 1u); break; } } } } while (0)
struct XcdBarrier { unsigned* bar; unsigned x; volatile LAS unsigned* st; };
DEVI XcdBarrier xcd_barrier_post(unsigned* bar, volatile LAS unsigned* st) {
  XcdBarrier b; b.bar = bar; b.x = xb_xcc_id(); b.st = st;
  if (threadIdx.x == 0) (void)xb_add(&bar[XB_XCNT(b.x)], 1u);
  return b;
}
DEVI void xcd_barrier_complete(unsigned* bar, unsigned x, unsigned& nloc, unsigned& nx) {
  const unsigned G = gridDim.x * gridDim.y * gridDim.z;
  unsigned sum, cnt, mine, sp = 0u;
  for (;;) {
    sum = 0u; cnt = 0u; mine = 0u;
#pragma unroll
    for (unsigned j = 0; j < 16; ++j) { const unsigned c = xb_ld(&bar[XB_XCNT(j)]); sum += c; cnt += (c > 0u) ? 1u : 0u; mine = (j == x) ? c : mine; }
    if (sum == G) break;
    __builtin_amdgcn_s_sleep(1);
    if ((++sp & 255u) == 0u) { if (xb_ld(&bar[XB_TMO])) break; if (sp > XB_SPIN_CAP) { atomicAdd(&bar[XB_TMO], 1u); break; } }
  }
  nloc = mine > 0u ? mine : 1u; nx = cnt > 0u ? cnt : 1u;
}
DEVI void xcd_barrier(const XcdBarrier& b) {
  asm volatile("s_waitcnt vmcnt(0)" ::: "memory");
  __syncthreads();
  if (threadIdx.x == 0) {
    unsigned* bar = b.bar;
    __builtin_amdgcn_s_waitcnt(0);
    unsigned nloc = b.st[0], nx = b.st[1];
    if (nloc == 0u) { xcd_barrier_complete(bar, b.x, nloc, nx); b.st[0] = nloc; b.st[1] = nx; }
    const unsigned old = xb_add(&bar[XB_XSUB(b.x)], 1u);
    const unsigned gen = old / nloc;
    if (old + 1u == (gen + 1u) * nloc) {
      __builtin_amdgcn_fence(__ATOMIC_RELEASE, "agent");
      asm volatile("s_waitcnt vmcnt(0)" ::: "memory");
      const unsigned og = xb_add(&bar[XB_TOP], 1u);
      const unsigned tg = og / nx;
      if (og + 1u == (tg + 1u) * nx) xb_add(&bar[XB_TOPGEN], 1u);
      else XB_SPIN(xb_ld(&bar[XB_TOPGEN]) == tg, bar);
      __builtin_amdgcn_fence(__ATOMIC_ACQUIRE, "agent");
      xb_add(&bar[XB_XGEN(b.x)], 1u);
      asm volatile("s_waitcnt vmcnt(0)" ::: "memory");
    } else {
      XB_SPIN(xb_ld(&bar[XB_XGEN(b.x)]) == gen, bar);
      __builtin_amdgcn_fence(__ATOMIC_ACQUIRE, "agent");
      asm volatile("s_waitcnt vmcnt(0)" ::: "memory");
    }
  }
  __syncthreads();
}

constexpr int BM = 256, BK = 64, HALFT = 128, HT = HALFT * BK;
DEVI int lds_byte(int r, int c) { int st = (r >> 4) * 2 + (c >> 5), rr = r & 15, cc = c & 31, ob = rr * 64 + cc * 2; return st * 1024 + (ob ^ (((ob >> 9) & 1) << 5)); }
DEVI void stage_rc(int b, int& R, int& C) { int st = b / 1024, sb = b % 1024, swz = sb ^ (((sb >> 9) & 1) << 5); R = (st >> 1) * 16 + swz / 64; C = (st & 1) * 32 + (swz % 64) / 2; }

struct NoHook { DEVI void operator()(f4 (&)[2][2][4][2], int, int, int, int, int, int, int) const {} };

template <class Epi, class Hook>
DEVI void gemm256(const hf* __restrict__ A, int lda, const hf* __restrict__ Bt, int ldb, int K, int nM, int nN, char* smem, const Epi& epi, const Hook& hook) {
  LAS unsigned char* lds = (LAS unsigned char*)smem;
  constexpr int HTB = HT * 2;
  const int tid = otid(), wid = __builtin_amdgcn_readfirstlane(tid >> 6), lane = tid & 63, wr = wid >> 2, wc = wid & 3, fr = lane & 15, fq = lane >> 4;
  unsigned voffA[2], voffB[2];
#pragma unroll
  for (int i = 0; i < 2; ++i) { int R, C; stage_rc(tid * 16 + i * 8192, R, C); voffA[i] = (unsigned)(R * lda + C) * 2u; voffB[i] = (unsigned)(R * ldb + C) * 2u; }
  const int kstep = BK * 2, hstepA = HALFT * lda * 2, hstepB = HALFT * ldb * 2;
  const __amdgpu_buffer_rsrc_t rA = __builtin_amdgcn_make_buffer_rsrc((void*)A, (short)0, 0x7fffffff, 0x00020000), rB = __builtin_amdgcn_make_buffer_rsrc((void*)Bt, (short)0, 0x7fffffff, 0x00020000);
  const unsigned ldsw = (unsigned)wid * 1024u;
  const int aoff = lds_byte(wr * 64 + fr, fq * 8), boff = lds_byte(wc * 32 + fr, fq * 8);
#define SA(b, h) (((b) * 2 + (h)) * HTB)
#define SB(b, h) ((4 + (b) * 2 + (h)) * HTB)
#define STAGE(bufoff, gbase, voff) do { _Pragma("unroll") for (int _i = 0; _i < 2; ++_i) \
    __builtin_amdgcn_raw_ptr_buffer_load_lds((&(voff)[0] == &voffA[0]) ? rA : rB, (LAS void*)(lds + (bufoff) + ldsw + _i * 8192), 16, (voff)[_i], (int)(gbase), 0, 0); } while (0)
#define LDA(dst, b, h) do { _Pragma("unroll") for (int m = 0; m < 4; ++m) _Pragma("unroll") for (int k = 0; k < 2; ++k) dst[m][k] = *(const LAS h8*)(lds + SA(b, h) + aoff + m * 2048 + k * 1024); } while (0)
#define LDB(dst, b, h) do { _Pragma("unroll") for (int n = 0; n < 2; ++n) _Pragma("unroll") for (int k = 0; k < 2; ++k) dst[n][k] = *(const LAS h8*)(lds + SB(b, h) + boff + n * 2048 + k * 1024); } while (0)
#define MMA(ai, bj, At_, Bt_) do { __builtin_amdgcn_s_setprio(1); \
    _Pragma("unroll") for (int m = 0; m < 4; ++m) _Pragma("unroll") for (int n = 0; n < 2; ++n) _Pragma("unroll") for (int k = 0; k < 2; ++k) \
      acc[ai][bj][m][n] = __builtin_amdgcn_mfma_f32_16x16x32_f16(Bt_[n][k], At_[m][k], acc[ai][bj][m][n], 0, 0, 0); \
    __builtin_amdgcn_s_setprio(0); } while (0)
#define WAIT_V(n) asm volatile("s_waitcnt vmcnt(" #n ")" ::: "memory")
#define WAIT_L(n) asm volatile("s_waitcnt lgkmcnt(" #n ")" ::: "memory")
#define BAR __builtin_amdgcn_s_barrier()
#define SCHED __builtin_amdgcn_sched_barrier(0)
  const int nwg = nM * nN;
  const int nt = K / BK;
  for (int L = obid(); L < nwg; L += gridDim.x) {
    int wgid = L;
    { const int q = nwg / 8, r = nwg % 8, xcd = wgid % 8, off = wgid / 8; wgid = (xcd < r ? xcd * (q + 1) : r * (q + 1) + (xcd - r) * q) + off; }
    const int WG_ = nN >= 16 ? 4 : 4;
    const int nig = WG_ * nN, gid = wgid / nig, fm = gid * WG_, gsz = min(nM - fm, WG_);
    const int pm = fm + ((wgid % nig) % gsz), pn = (wgid % nig) / gsz, brow = pm * BM, bcol = pn * BM;
    const int cA = brow * lda * 2, cB = bcol * ldb * 2;
    __syncthreads();
    f4 acc[2][2][4][2];
#pragma unroll
    for (int a = 0; a < 2; ++a)
#pragma unroll
      for (int b = 0; b < 2; ++b)
#pragma unroll
        for (int m = 0; m < 4; ++m)
#pragma unroll
          for (int n = 0; n < 2; ++n) acc[a][b][m][n] = (f4){0.f, 0.f, 0.f, 0.f};
    h8 At[4][2], B0[2][2], B1[2][2];
    STAGE(SB(0, 0), cB, voffB); STAGE(SA(0, 0), cA, voffA); STAGE(SB(0, 1), cB + hstepB, voffB); STAGE(SA(0, 1), cA + hstepA, voffA);
    if (wr == 1) BAR;
    WAIT_V(4); BAR;
    STAGE(SB(1, 0), cB + kstep, voffB); STAGE(SA(1, 0), cA + kstep, voffA); STAGE(SB(1, 1), cB + hstepB + kstep, voffB);
    WAIT_V(6); BAR;
    for (int t = 0; t < nt - 2; t += 2) {
      hook(acc, t, brow, bcol, wr, wc, fr, fq);
      const int a1 = cA + (t + 1) * kstep, a2 = a1 + kstep, a3 = a2 + kstep;
      const int b2 = cB + (t + 2) * kstep, b3 = b2 + kstep;
      LDB(B0, 0, 0); SCHED; LDA(At, 0, 0); STAGE(SA(1, 1), a1 + hstepA, voffA);
      WAIT_L(8); BAR; WAIT_L(0); MMA(0, 0, At, B0); BAR; SCHED;
      LDB(B1, 0, 1); STAGE(SB(0, 0), b2, voffB);
      BAR; WAIT_L(0); MMA(0, 1, At, B1); BAR;
      LDA(At, 0, 1); STAGE(SA(0, 0), a2, voffA);
      BAR; WAIT_L(0); MMA(1, 0, At, B0); BAR; SCHED;
      STAGE(SB(0, 1), b2 + hstepB, voffB);
      WAIT_V(6); BAR; MMA(1, 1, At, B1); BAR;
      LDB(B0, 1, 0); SCHED; LDA(At, 1, 0); STAGE(SA(0, 1), a2 + hstepA, voffA);
      WAIT_L(8); BAR; WAIT_L(0); MMA(0, 0, At, B0); BAR; SCHED;
      LDB(B1, 1, 1); STAGE(SB(1, 0), b3, voffB);
      BAR; WAIT_L(0); MMA(0, 1, At, B1); BAR;
      LDA(At, 1, 1); STAGE(SA(1, 0), a3, voffA);
      BAR; WAIT_L(0); MMA(1, 0, At, B0); BAR; SCHED;
      STAGE(SB(1, 1), b3 + hstepB, voffB);
      WAIT_V(6); BAR; MMA(1, 1, At, B1); BAR;
    }
    { LDB(B0, 0, 0); LDA(At, 0, 0); STAGE(SA(1, 1), cA + (nt - 1) * kstep + hstepA, voffA);
      BAR; WAIT_L(0); MMA(0, 0, At, B0); BAR;
      LDB(B1, 0, 1); BAR; WAIT_L(0); MMA(0, 1, At, B1); BAR;
      LDA(At, 0, 1); WAIT_V(4); BAR; WAIT_L(0); MMA(1, 0, At, B0); MMA(1, 1, At, B1); BAR; }
    { LDB(B0, 1, 0); LDA(At, 1, 0); WAIT_V(2); BAR; WAIT_L(0); MMA(0, 0, At, B0); BAR;
      LDB(B1, 1, 1); WAIT_V(0); BAR; WAIT_L(0); MMA(0, 1, At, B1); BAR;
      LDA(At, 1, 1); BAR; WAIT_L(0); MMA(1, 0, At, B0); MMA(1, 1, At, B1); BAR; }
    if (wr == 0) BAR;
    { int fr2 = fr, fq2 = fq, brow2 = brow, bcol2 = bcol; asm volatile("" : "+v"(fr2), "+v"(fq2)); asm volatile("" : "+s"(brow2), "+s"(bcol2));
      epi(acc, brow2, bcol2, wr, wc, fr2, fq2); }
  }
#undef SA
#undef SB
}

template <int MT, class AF, class BF, class EF>
DEVI void sgemm_tile(int K, const AF& af, const BF& bf, const EF& ef, char* smem) {
  hf* As = (hf*)smem;
  hf* Bs = As + 64 * MT * 136;
  const int tid = otid(), w = __builtin_amdgcn_readfirstlane(tid >> 6), lane = tid & 63, wr = w >> 1, wc = w & 1, fr = lane & 15, fq = lane >> 4;
  const int lr = tid >> 4, lk = (tid & 15) * 8;
  f4 acc[MT][2];
#pragma unroll
  for (int m = 0; m < MT; ++m)
#pragma unroll
    for (int n = 0; n < 2; ++n) acc[m][n] = (f4){0.f, 0.f, 0.f, 0.f};
  h8 ra[2 * MT], rb[2];
#pragma unroll
  for (int i = 0; i < 2 * MT; ++i) ra[i] = *(const h8*)af(lr + 32 * i, lk);
#pragma unroll
  for (int i = 0; i < 2; ++i) rb[i] = *(const h8*)bf(lr + 32 * i, lk);
  for (int k0 = 0; k0 < K; k0 += 128) {
    __syncthreads();
#pragma unroll
    for (int i = 0; i < 2 * MT; ++i) *(h8*)(As + (lr + 32 * i) * 136 + lk) = ra[i];
#pragma unroll
    for (int i = 0; i < 2; ++i) *(h8*)(Bs + (lr + 32 * i) * 136 + lk) = rb[i];
    __syncthreads();
    if (k0 + 128 < K) {
#pragma unroll
      for (int i = 0; i < 2 * MT; ++i) ra[i] = *(const h8*)af(lr + 32 * i, k0 + 128 + lk);
#pragma unroll
      for (int i = 0; i < 2; ++i) rb[i] = *(const h8*)bf(lr + 32 * i, k0 + 128 + lk);
    }
#pragma unroll
    for (int ks = 0; ks < 4; ++ks) {
      h8 a[MT], b[2];
#pragma unroll
      for (int m = 0; m < MT; ++m) a[m] = *(const h8*)(As + (wr * 16 * MT + m * 16 + fr) * 136 + ks * 32 + fq * 8);
#pragma unroll
      for (int n = 0; n < 2; ++n) b[n] = *(const h8*)(Bs + (wc * 32 + n * 16 + fr) * 136 + ks * 32 + fq * 8);
#pragma unroll
      for (int m = 0; m < MT; ++m)
#pragma unroll
        for (int n = 0; n < 2; ++n) acc[m][n] = __builtin_amdgcn_mfma_f32_16x16x32_f16(b[n], a[m], acc[m][n], 0, 0, 0);
    }
  }
#pragma unroll
  for (int m = 0; m < MT; ++m)
#pragma unroll
    for (int n = 0; n < 2; ++n) ef(wr * 16 * MT + m * 16 + fr, wc * 32 + n * 16 + fq * 4, acc[m][n]);
}

DEVI int srccol(int map, int n) {
  if (map == 0) {
    const int hc = n >> 7, pc = n & 127;
    int lc = pc;
    if ((hc >= 8 && hc <= 12) || hc == 14 || hc == 16) { const int wc = pc >> 5, nn = (pc >> 4) & 1, q = pc & 15; lc = (wc >> 1) * 64 + (wc & 1) * 16 + q + 32 * nn; }
    if (hc < 18) return hc * 128 + lc;
    if (hc == 18) return lc < 24 ? 2304 + lc : -1;
    return -1;
  }
  if (map == 3) return 2328 + n;
  if (map == 1) { const int pn = n >> 8, bj = (n >> 7) & 1, i = n & 127; return bj * 512 + pn * 128 + i; }
  if (map == 2) { const int pn = n >> 8, bj = (n >> 7) & 1, i = n & 127, wc = i >> 5, nn = (i >> 4) & 1, q = i & 15;
                  return bj * FFH + pn * 128 + wc * 32 + (q >> 2) * 8 + nn * 4 + (q & 3); }
  return n;
}

DEVI void tconv(const float* __restrict__ src, int ldS, hf* __restrict__ dst, int ldD, int Kr, int Np, int map, int& rot, char* smem) {
  hf* tl = (hf*)smem;
  const int nkt = Kr / 64, nnt = Np / 64, tid = otid(), ntl = nkt * nnt;
  const int G = gridDim.x;
  const int first = (int)((obid() + G - (rot % G)) % G);
  rot += ntl;
  for (int tIdx = first; tIdx < ntl; tIdx += G) {
    const int kt = tIdx % nkt, ntile = tIdx / nkt;
    const int n = tid & 63, kk = tid >> 6;
    const int sc = srccol(map, ntile * 64 + n);
    __syncthreads();
#pragma unroll
    for (int i = 0; i < 8; ++i) { const int k = i * 8 + kk; const float v = sc >= 0 ? src[(size_t)(kt * 64 + k) * ldS + sc] : 0.f; tl[k * 66 + n] = (hf)v; }
    __syncthreads();
    const int n2 = tid >> 3, k8 = (tid & 7) * 8;
    h8 o;
#pragma unroll
    for (int i = 0; i < 8; ++i) o[i] = tl[(k8 + i) * 66 + n2];
    *(h8*)(dst + (size_t)(ntile * 64 + n2) * ldD + kt * 64 + k8) = o;
  }
}

DEVI void tconv_big(const float* __restrict__ src, int ldS, hf* __restrict__ dst, int ldD, int Kr, int Np, int map, int& rot, char* smem) {
  hf* tl = (hf*)smem;
  const int nkt = Kr / 64, nnt = Np / 256, tid = otid(), ntl = nkt * nnt;
  const int G = gridDim.x;
  const int first = (int)((obid() + G - (rot % G)) % G);
  rot += ntl;
  for (int tIdx = first; tIdx < ntl; tIdx += G) {
    const int kt = tIdx % nkt, ntile = tIdx / nkt;
    const int n4 = (tid & 63) * 4, kk = tid >> 6;
    const int sc = srccol(map, ntile * 256 + n4);
    f4 v[8];
#pragma unroll
    for (int i = 0; i < 8; ++i) v[i] = sc >= 0 ? *(const f4*)(src + (size_t)(kt * 64 + i * 8 + kk) * ldS + sc) : (f4){0.f, 0.f, 0.f, 0.f};
    __syncthreads();
#pragma unroll
    for (int i = 0; i < 8; ++i) *(h4*)(tl + (i * 8 + kk) * 264 + n4) = pack4(v[i]);
    __syncthreads();
#pragma unroll
    for (int q = 0; q < 4; ++q) {
      const int n2 = (tid >> 3) + q * 64, k8 = (tid & 7) * 8;
      h8 o;
#pragma unroll
      for (int i = 0; i < 8; ++i) o[i] = tl[(k8 + i) * 264 + n2];
      *(h8*)(dst + (size_t)(ntile * 256 + n2) * ldD + kt * 64 + k8) = o;
    }
  }
}

DEVI void lampow(float ar, float ai, double dt, int n, double& re, double& im) {
  const double m = exp((double)ar * dt * n), ang = (double)ai * dt * n;
  re = m * cos(ang); im = m * sin(ang);
}
DEVI void zohcoef(float ar, float ai, double dt, double& re, double& im) {
  double lr, li; lampow(ar, ai, dt, 1, lr, li);
  const double nr = lr - 1.0, ni = li, dr = (double)ar, di = (double)ai, den = dr * dr + di * di;
  re = (nr * dr + ni * di) / den; im = (ni * dr - nr * di) / den;
}

DEVI void w_ffo(const P& p, int l, char* smem) {
  int rot = 0;
  tconv_big(p.ffn_w_out + (size_t)l * FFH * 1024, 1024, (hf*)(p.ws + OFF_BTFO), FFH, FFH, 1024, 9, rot, smem);
}
DEVI void phase_w(const P& p, int l, char* smem) {
  char* ws = p.ws;
  int rot = 0;
  tconv_big(p.w_in + (size_t)l * 1024 * 5400, 5400, (hf*)(ws + OFF_BTIN), 1024, 1024, (int)NINA, 0, rot, smem);
  tconv_big(p.w_in + (size_t)l * 1024 * 5400, 5400, (hf*)(ws + OFF_BTIN) + NINA * 1024, 1024, 1024, (int)NINB, 3, rot, smem);
  tconv_big(p.ffn_w_in + (size_t)l * 1024 * 5632, 5632, (hf*)(ws + OFF_BTFI), 1024, 1024, 5632, 2, rot, smem);
  tconv_big(p.w_out + (size_t)l * 1024 * 1024, 1024, (hf*)(ws + OFF_BTWO), 1024, 1024, 1024, 9, rot, smem);
  for (int k = 0; k < 3; ++k) tconv_big(p.w_branch + ((size_t)l * 3 + k) * 512 * 1024, 1024, (hf*)(ws + OFF_BTBR) + k * 512, 1536, 512, 1024, 9, rot, smem);
  tconv_big(p.w_glu + (size_t)l * 512 * 1024, 1024, (hf*)(ws + OFF_BTGLU), 512, 512, 1024, 1, rot, smem);
  for (int j = 0; j < 2; ++j) tconv_big(p.cmp_w1 + ((size_t)l * 2 + j) * 2048 * 256, 256, (hf*)(ws + OFF_BTC1) + (size_t)j * 256 * 2048, 2048, 2048, 256, 9, rot, smem);
  for (int j = 0; j < 2; ++j) tconv(p.cmp_w2 + ((size_t)l * 2 + j) * 256 * 64, 64, (hf*)(ws + OFF_BTC2) + (size_t)j * 64 * 256, 256, 256, 64, 9, rot, smem);
  for (int g = 0; g < 4; ++g) tconv(p.pool_w + ((size_t)l * 4 + g) * 128 * 128, 128, (hf*)(ws + OFF_BTPOOL) + (size_t)g * 128 * 128, 128, 128, 128, 9, rot, smem);

  const int gtid = obid() * 512 + otid(), gnt = gridDim.x * 512;
    const float* bre = p.b_re + (size_t)l * 32768; const float* bim = p.b_im + (size_t)l * 32768;
  const float* cre = p.c_re + (size_t)l * 32768; const float* cim = p.c_im + (size_t)l * 32768;
  hf* WC = (hf*)(ws + OFF_WC); hf* W1 = (hf*)(ws + OFF_W1); float* LAM16 = (float*)(ws + OFF_LAM16);
  const f2* E = (const f2*)(ws + OFF_ETAB) + (size_t)l * 2048 * 18;
  const float* DT = (const float*)(ws + OFF_CB1 + 2048) + l * 32;
  for (int idx = gtid; idx < 32 * 16 * 256; idx += gnt) {
    const int ci = idx & 15, co = (idx >> 4) & 15, d = (idx >> 8) & 15, g = idx >> 12;
    const float dt = DT[g];
    float sum = 0.f;
    for (int pp = 0; pp < 64; ++pp) {
      const f2 z = E[(g * 64 + pp) * 18 + 17], e = E[(g * 64 + pp) * 18 + d];
      const float br = bre[(g * 64 + pp) * 16 + ci], bi = bim[(g * 64 + pp) * 16 + ci];
      const float bbr = z[0] * br - z[1] * bi, bbi = z[0] * bi + z[1] * br;
      const float tr = e[0] * bbr - e[1] * bbi, ti = e[0] * bbi + e[1] * bbr;
      sum += cre[(g * 16 + co) * 64 + pp] * tr - cim[(g * 16 + co) * 64 + pp] * ti;
    }
    const hf v = (hf)(sum / dt);
    for (int t = d; t < 16; ++t) WC[((size_t)g * 256 + t * 16 + co) * 384 + (t - d) * 16 + ci] = v;
    if (d >= 1) for (int t = 0; t + d < 16; ++t) WC[((size_t)g * 256 + t * 16 + co) * 384 + (t + d) * 16 + ci] = (hf)0.f;
  }
  for (int idx = gtid; idx < 32 * 16 * 16 * 64; idx += gnt) {
    const int pp = idx & 63, co = (idx >> 6) & 15, t = (idx >> 10) & 15, g = idx >> 14;
    const f2 e = E[(g * 64 + pp) * 18 + t + 1];
    const float cr = cre[(g * 16 + co) * 64 + pp], cii = cim[(g * 16 + co) * 64 + pp];
    WC[((size_t)g * 256 + t * 16 + co) * 384 + 256 + pp] = (hf)(cr * e[0] - cii * e[1]);
    WC[((size_t)g * 256 + t * 16 + co) * 384 + 320 + pp] = (hf)(-(cr * e[1] + cii * e[0]));
  }
  for (int idx = gtid; idx < 32 * 64 * 256; idx += gnt) {
    const int ci = idx & 15, j = (idx >> 4) & 15, pp = (idx >> 8) & 63, g = idx >> 14;
    const float dt = DT[g];
    const f2 z = E[(g * 64 + pp) * 18 + 17], e = E[(g * 64 + pp) * 18 + 15 - j];
    const float br = bre[(g * 64 + pp) * 16 + ci], bi = bim[(g * 64 + pp) * 16 + ci];
    const float bbr = z[0] * br - z[1] * bi, bbi = z[0] * bi + z[1] * br;
    W1[((size_t)g * 128 + pp) * 256 + j * 16 + ci] = (hf)((e[0] * bbr - e[1] * bbi) / dt);
    W1[((size_t)g * 128 + 64 + pp) * 256 + j * 16 + ci] = (hf)((e[0] * bbi + e[1] * bbr) / dt);
  }
  for (int idx = gtid; idx < 2048; idx += gnt) { const f2 e = E[idx * 18 + 16]; LAM16[idx * 2] = e[0]; LAM16[idx * 2 + 1] = e[1]; }
  {
    float* red = (float*)(smem + 40960);
    float* CB1 = (float*)(ws + OFF_CB1);
    for (int job = obid(); job < 64; job += gridDim.x) {
      const int tj = otid(); const int j = job >> 5, cg8 = job & 31, c = tj & 7, kl = tj >> 3;
      const float* w1 = p.cmp_w1 + ((size_t)l * 2 + j) * 2048 * 256; const float* ps = p.cmp_pos + ((size_t)l * 2 + j) * 2048;
      float s = 0.f;
      for (int k = kl; k < 2048; k += 64) s += ps[k] * w1[(size_t)k * 256 + cg8 * 8 + c];
      __syncthreads();
      red[kl * 8 + c] = s;
      __syncthreads();
      if (tj < 8) { float tot = 0.f; for (int i = 0; i < 64; ++i) tot += red[i * 8 + tj]; CB1[j * 256 + cg8 * 8 + tj] = tot + p.cmp_b1[(l * 2 + j) * 256 + cg8 * 8 + tj]; }
    }
  }
}

DEVI void phase_0(const P& p) {
  const int gtid = obid() * 512 + otid(), gnt = gridDim.x * 512;
  f2* rope = (f2*)(p.ws + OFF_ROPE);
  for (int idx = gtid; idx < T_ * 32; idx += gnt) {
    const int i = idx & 31, t = idx >> 5;
    const double inv = exp(-(double)i * (9.210340371976184 / 32.0));
    const double ang = (double)p.pos[t] * inv;
    rope[idx] = (f2){(float)cos(ang), (float)sin(ang)};
  }
  f2* ET = (f2*)(p.ws + OFF_ETAB);
  for (int idx = gtid; idx < DEPTH_ * 2048 * 18; idx += gnt) {
    const int d = idx % 18, gp = idx / 18;
    const double dt = exp((double)p.log_dt[gp >> 6]);
    double re, im;
    if (d < 17) lampow(p.a_re[gp], p.a_im[gp], dt, d, re, im); else zohcoef(p.a_re[gp], p.a_im[gp], dt, re, im);
    ET[idx] = (f2){(float)re, (float)im};
  }
  if (gtid < DEPTH_ * 32) ((float*)(p.ws + OFF_CB1 + 2048))[gtid] = (float)exp((double)p.log_dt[gtid]);
  hf* XH = (hf*)(p.ws + OFF_XH);
  for (int idx = gtid; idx < T_ * 1024 / 4; idx += gnt) { const f4 v = ((const f4*)p.x)[idx]; *(h4*)(XH + (size_t)idx * 4) = pack4(v); }
}

DEVI void phase_ln(float* X, hf* XH, const float* __restrict__ g, const float* __restrict__ b) {
  const int tid_ = otid(), lane = tid_ & 63, gw = obid() * 8 + (tid_ >> 6), nw = gridDim.x * 8;
  for (int row = gw; row < T_; row += nw) {
    float* xr = X + (size_t)row * 1024;
    f4 v[4];
    float s = 0.f;
#pragma unroll
    for (int i = 0; i < 4; ++i) { v[i] = *(const f4*)(xr + i * 256 + lane * 4); s += (v[i][0] + v[i][1]) + (v[i][2] + v[i][3]); }
#pragma unroll
    for (int o = 32; o >= 1; o >>= 1) s += __shfl_xor(s, o);
    const float mu = s * (1.0f / 1024.0f);
    float q = 0.f;
#pragma unroll
    for (int i = 0; i < 4; ++i) { const f4 d = v[i] - mu; q += (d[0] * d[0] + d[1] * d[1]) + (d[2] * d[2] + d[3] * d[3]); }
#pragma unroll
    for (int o = 32; o >= 1; o >>= 1) q += __shfl_xor(q, o);
    const float rstd = rsqrtf(q * (1.0f / 1024.0f) + 1e-5f);
#pragma unroll
    for (int i = 0; i < 4; ++i) {
      const f4 gg = *(const f4*)(g + i * 256 + lane * 4), bb = *(const f4*)(b + i * 256 + lane * 4);
      const f4 y = (v[i] - mu) * rstd * gg + bb;
      *(f4*)(xr + i * 256 + lane * 4) = y;
      *(h4*)(XH + (size_t)row * 1024 + i * 256 + lane * 4) = pack4(y);
    }
  }
}

struct EpiIn {
  char* ws;
  DEVI void operator()(const f4 (&acc)[2][2][4][2], int brow, int bcol, int wr, int wc, int fr, int fq) const {
    const f2* rope = (const f2*)(ws + OFF_ROPE);
#pragma unroll
    for (int bj = 0; bj < 2; ++bj) {
      const int hc = (bcol >> 7) + bj;
      if (hc < 4) {
        hf* U = (hf*)(ws + OFF_USSM);
#pragma unroll
        for (int ai = 0; ai < 2; ++ai)
#pragma unroll
          for (int m = 0; m < 4; ++m) {
            __builtin_amdgcn_sched_barrier(0); const int t = brow + ai * 128 + wr * 64 + m * 16 + fr;
#pragma unroll
            for (int n = 0; n < 2; ++n) *(h4*)(U + ((size_t)(hc * 8 + wc * 2 + n) * 1024 + (t >> 4)) * 384 + (t & 15) * 16 + fq * 4) = pack4(acc[ai][bj][m][n]);
          }
      } else if (hc < 8) {
        hf* U = (hf*)(ws + OFF_UPOOL);
#pragma unroll
        for (int ai = 0; ai < 2; ++ai)
#pragma unroll
          for (int m = 0; m < 4; ++m) {
            __builtin_amdgcn_sched_barrier(0); const int t = brow + ai * 128 + wr * 64 + m * 16 + fr;
#pragma unroll
            for (int n = 0; n < 2; ++n) *(h4*)(U + (size_t)t * 512 + (hc - 4) * 128 + wc * 32 + n * 16 + fq * 4) = pack4(acc[ai][bj][m][n]);
          }
      } else if (hc < 18) {
        const bool isq = hc < 12;
        const int kvi = hc - 12;
        const bool dorope = isq || ((kvi & 1) == 0);
#pragma unroll
        for (int ai = 0; ai < 2; ++ai)
#pragma unroll
          for (int m = 0; m < 4; ++m) {
            __builtin_amdgcn_sched_barrier(0); const int t = brow + ai * 128 + wr * 64 + m * 16 + fr;
            hf* dst = isq ? (hf*)(ws + OFF_Q) + (size_t)t * 512 + ((hc - 8) * 2 + (wc >> 1)) * 64
                          : (hf*)(ws + OFF_KV + (size_t)kvi * SZ_KV1) + ((size_t)(wc >> 1) * T_ + t) * 64;
            const f4 v0 = acc[ai][bj][m][0], v1 = acc[ai][bj][m][1];
            if (dorope) {
              const int d1 = (wc & 1) * 16 + fq * 4;
              const f4 cs0 = *(const f4*)(rope + (size_t)t * 32 + d1), cs1 = *(const f4*)(rope + (size_t)t * 32 + d1 + 2);
              f4 o1, o2;
              o1[0] = v0[0] * cs0[0] - v1[0] * cs0[1]; o2[0] = v0[0] * cs0[1] + v1[0] * cs0[0];
              o1[1] = v0[1] * cs0[2] - v1[1] * cs0[3]; o2[1] = v0[1] * cs0[3] + v1[1] * cs0[2];
              o1[2] = v0[2] * cs1[0] - v1[2] * cs1[1]; o2[2] = v0[2] * cs1[1] + v1[2] * cs1[0];
              o1[3] = v0[3] * cs1[2] - v1[3] * cs1[3]; o2[3] = v0[3] * cs1[3] + v1[3] * cs1[2];
              *(h4*)(dst + d1) = pack4(o1); *(h4*)(dst + d1 + 32) = pack4(o2);
            } else {
              const int d = (wc & 1) * 32 + fq * 4;
              *(h4*)(dst + d) = pack4(v0); *(h4*)(dst + d + 16) = pack4(v1);
            }
          }
      } else if (hc == 18) {
        float* NG = (float*)(ws + OFF_NSAG);
        if (wc == 0) {
#pragma unroll
          for (int ai = 0; ai < 2; ++ai)
#pragma unroll
            for (int m = 0; m < 4; ++m) {
              __builtin_amdgcn_sched_barrier(0); const int t = brow + ai * 128 + wr * 64 + m * 16 + fr;
#pragma unroll
              for (int n = 0; n < 2; ++n) {
                const int c = n * 16 + fq * 4;
                if (c < 24) { f4 v = acc[ai][bj][m][n];
#pragma unroll
                  for (int j = 0; j < 4; ++j) v[j] = sigmoidf_(v[j]);
                  *(f4*)(NG + (size_t)t * 24 + c) = v; }
              }
            }
        }
      }
    }
  }
};

struct EpiGate {
  unsigned char* G;
  DEVI void operator()(const f4 (&acc)[2][2][4][2], int brow, int bcol, int wr, int wc, int fr, int fq) const {
#pragma unroll
    for (int ai = 0; ai < 2; ++ai)
#pragma unroll
      for (int m = 0; m < 4; ++m) {
        __builtin_amdgcn_sched_barrier(0);
        const int t = brow + ai * 128 + wr * 64 + m * 16 + fr;
#pragma unroll
        for (int bj = 0; bj < 2; ++bj)
#pragma unroll
          for (int n = 0; n < 2; ++n) {
            const f4 v = acc[ai][bj][m][n];
            unsigned w = 0u;
#pragma unroll
            for (int j = 0; j < 4; ++j) { const float gq = fminf(fmaxf(sigmoidf_(v[j]) * 255.0f + 0.5f, 1.0f), 255.0f); w |= ((unsigned)gq) << (8 * j); }
            *(unsigned*)(G + (size_t)t * 3072 + bcol + bj * 128 + wc * 32 + n * 16 + fq * 4) = w;
          }
      }
  }
};

struct EpiGlu {
  hf* Y;
  DEVI void operator()(const f4 (&acc)[2][2][4][2], int brow, int bcol, int wr, int wc, int fr, int fq) const {
#pragma unroll
    for (int ai = 0; ai < 2; ++ai)
#pragma unroll
      for (int m = 0; m < 4; ++m) {
        __builtin_amdgcn_sched_barrier(0); const int t = brow + ai * 128 + wr * 64 + m * 16 + fr;
#pragma unroll
        for (int n = 0; n < 2; ++n) {
          const f4 a = acc[ai][0][m][n], g = acc[ai][1][m][n]; f4 o;
#pragma unroll
          for (int j = 0; j < 4; ++j) o[j] = a[j] * sigmoidf_(g[j]);
          *(h4*)(Y + (size_t)t * 1536 + (bcol >> 1) + wc * 32 + n * 16 + fq * 4) = pack4(o);
        }
      }
  }
};

struct EpiSwiglu {
  hf* H;
  DEVI void operator()(const f4 (&acc)[2][2][4][2], int brow, int bcol, int wr, int wc, int fr, int fq) const {
#pragma unroll
    for (int ai = 0; ai < 2; ++ai)
#pragma unroll
      for (int m = 0; m < 4; ++m) {
        __builtin_amdgcn_sched_barrier(0); const int t = brow + ai * 128 + wr * 64 + m * 16 + fr;
        h8 o;
#pragma unroll
        for (int n = 0; n < 2; ++n) {
          const f4 g = acc[ai][0][m][n], u = acc[ai][1][m][n];
#pragma unroll
          for (int j = 0; j < 4; ++j) o[n * 4 + j] = (hf)(g[j] * sigmoidf_(g[j]) * u[j]);
        }
        *(h8*)(H + (size_t)t * FFH + (bcol >> 1) + wc * 32 + fq * 8) = o;
      }
  }
};

struct HookMerge {
  const unsigned char* G;
  DEVI void operator()(f4 (&acc)[2][2][4][2], int t, int brow, int bcol, int wr, int wc, int fr, int fq) const {
    if (t != 8 && t != 16) return;
    const int k = (t >> 3) - 1;
    asm volatile("" : "+v"(fr), "+v"(fq));
#pragma unroll
    for (int ai = 0; ai < 2; ++ai) { __builtin_amdgcn_sched_barrier(0);
#pragma unroll
      for (int m = 0; m < 4; ++m) {
        const int row = brow + ai * 128 + wr * 64 + m * 16 + fr;
#pragma unroll
        for (int bj = 0; bj < 2; ++bj)
#pragma unroll
          for (int n = 0; n < 2; ++n) {
            const int col = bcol + bj * 128 + wc * 32 + n * 16 + fq * 4;
            const unsigned wa = *(const unsigned*)(G + (size_t)row * 3072 + k * 1024 + col), wb = *(const unsigned*)(G + (size_t)row * 3072 + (k + 1) * 1024 + col);
#pragma unroll
            for (int j = 0; j < 4; ++j) acc[ai][bj][m][n][j] *= (float)((wa >> (8 * j)) & 255u) * frcp((float)((wb >> (8 * j)) & 255u));
          }
      }
    }
  }
};
struct EpiMerge {
  const unsigned char* G; hf* M;
  DEVI void operator()(const f4 (&acc)[2][2][4][2], int brow, int bcol, int wr, int wc, int fr, int fq) const {
#pragma unroll
    for (int ai = 0; ai < 2; ++ai) { __builtin_amdgcn_sched_barrier(0);
#pragma unroll
      for (int m = 0; m < 4; ++m) {
        const int row = brow + ai * 128 + wr * 64 + m * 16 + fr;
#pragma unroll
        for (int bj = 0; bj < 2; ++bj)
#pragma unroll
          for (int n = 0; n < 2; ++n) {
            const int col = bcol + bj * 128 + wc * 32 + n * 16 + fq * 4;
            const unsigned w2 = *(const unsigned*)(G + (size_t)row * 3072 + 2048 + col);
            f4 o = acc[ai][bj][m][n];
#pragma unroll
            for (int j = 0; j < 4; ++j) o[j] *= (float)((w2 >> (8 * j)) & 255u) * (1.0f / 255.0f);
            *(h4*)(M + (size_t)row * 1024 + col) = pack4(o);
          }
      }
    }
  }
};
struct EpiRes {
  const float* resf; const hf* resh; float* X; hf* XH; const float* g; const float* b; unsigned long long* xbuf; unsigned* cnt; unsigned want; char* smem;
  DEVI void operator()(f4 (&acc)[2][2][4][2], int brow, int bcol, int wr, int wc, int fr, int fq) const {
    const int pm = brow >> 8, pn = bcol >> 8;
    const int tid = otid(), wid = __builtin_amdgcn_readfirstlane(tid >> 6), lane = tid & 63;
    f2* Pt = (f2*)smem;
    f2* S = (f2*)(smem + 8192);
#pragma unroll
    for (int ai = 0; ai < 2; ++ai) { __builtin_amdgcn_sched_barrier(0);
#pragma unroll
      for (int m = 0; m < 4; ++m) {
        const int row = brow + ai * 128 + wr * 64 + m * 16 + fr;
        float s1 = 0.f, s2 = 0.f;
#pragma unroll
        for (int bj = 0; bj < 2; ++bj)
#pragma unroll
          for (int n = 0; n < 2; ++n) {
            const size_t o = (size_t)row * 1024 + bcol + bj * 128 + wc * 32 + n * 16 + fq * 4;
            f4 rv;
            if (resf) rv = *(const f4*)(resf + o); else { const h4 rh = *(const h4*)(resh + o); rv = (f4){(float)rh[0], (float)rh[1], (float)rh[2], (float)rh[3]}; }
            const f4 y = rv * ALPHA + acc[ai][bj][m][n];
            acc[ai][bj][m][n] = y;
            s1 += (y[0] + y[1]) + (y[2] + y[3]); s2 += (y[0] * y[0] + y[1] * y[1]) + (y[2] * y[2] + y[3] * y[3]);
          }
        s1 += __shfl_xor(s1, 16); s1 += __shfl_xor(s1, 32); s2 += __shfl_xor(s2, 16); s2 += __shfl_xor(s2, 32);
        if (fq == 0) Pt[(ai * 128 + wr * 64 + m * 16 + fr) * 4 + wc] = (f2){s1, s2};
      }
    }
    __syncthreads();
    if (tid < 256) {
      const f2 a = Pt[tid * 4 + 0], b2 = Pt[tid * 4 + 1], c = Pt[tid * 4 + 2], d = Pt[tid * 4 + 3];
      const float sm = (a[0] + b2[0]) + (c[0] + d[0]), sq = (a[1] + b2[1]) + (c[1] + d[1]);
      __hip_atomic_store(xbuf + ((size_t)(pm * 256 + tid) * 4 + pn), ((unsigned long long)__float_as_uint(sq) << 32) | __float_as_uint(sm), __ATOMIC_RELAXED, __HIP_MEMORY_SCOPE_AGENT);
    }
    asm volatile("s_waitcnt vmcnt(0)" ::: "memory");
    if (wid < 4 && lane == 0) __hip_atomic_fetch_add(cnt + 64 * pm, 1u, __ATOMIC_RELAXED, __HIP_MEMORY_SCOPE_AGENT);
    if (wid == 0) {
      unsigned sp = 0;
      while ((unsigned)__builtin_amdgcn_readfirstlane(__hip_atomic_load(cnt + 64 * pm, __ATOMIC_RELAXED, __HIP_MEMORY_SCOPE_AGENT)) < want) { __builtin_amdgcn_s_sleep(2); if (++sp > (1u << 22)) break; }
      __builtin_amdgcn_fence(__ATOMIC_ACQUIRE, "agent");
    }
    asm volatile("s_waitcnt vmcnt(0) lgkmcnt(0)" ::: "memory");
    __syncthreads();
    if (tid < 256) {
      const unsigned long long* slot = xbuf + (size_t)(pm * 256 + tid) * 4;
      float sm = 0.f, sq = 0.f;
#pragma unroll
      for (int t = 0; t < 4; ++t) { const unsigned long long w = __hip_atomic_load(slot + t, __ATOMIC_RELAXED, __HIP_MEMORY_SCOPE_AGENT); sm += __uint_as_float((unsigned)w); sq += __uint_as_float((unsigned)(w >> 32)); }
      const float mu = sm * (1.0f / 1024.0f), var = sq * (1.0f / 1024.0f) - mu * mu;
      S[tid] = (f2){mu, rsqrtf(var + 1e-5f)};
    }
    __syncthreads();
    f4 gg[2][2], bb[2][2];
#pragma unroll
    for (int bj = 0; bj < 2; ++bj)
#pragma unroll
      for (int n = 0; n < 2; ++n) { const int col = bcol + bj * 128 + wc * 32 + n * 16 + fq * 4; gg[bj][n] = *(const f4*)(g + col); bb[bj][n] = *(const f4*)(b + col); }
#pragma unroll
    for (int ai = 0; ai < 2; ++ai) { __builtin_amdgcn_sched_barrier(0);
#pragma unroll
      for (int m = 0; m < 4; ++m) {
        const int rl = ai * 128 + wr * 64 + m * 16 + fr;
        const f2 st = S[rl];
#pragma unroll
        for (int bj = 0; bj < 2; ++bj)
#pragma unroll
          for (int n = 0; n < 2; ++n) {
            const size_t o = (size_t)(brow + rl) * 1024 + bcol + bj * 128 + wc * 32 + n * 16 + fq * 4;
            const f4 y = (acc[ai][bj][m][n] - st[0]) * st[1] * gg[bj][n] + bb[bj][n];
            if (X) *(f4*)(X + o) = y;
            if (XH) *(h4*)(XH + o) = pack4(y);
          }
      }
    }
  }
};


DEVI void ssm_c_tile(const P& p, int l, int g, int mt, int nt, char* smem) {
  char* ws = p.ws;
  const hf* A = (const hf*)(ws + OFF_USSM) + ((size_t)g * 1024 + mt * 128) * 384;
  const hf* Bt = (const hf*)(ws + OFF_WC) + ((size_t)g * 256 + nt * 64) * 384;
  const float dt = ((const float*)(ws + OFF_CB1 + 2048))[l * 32 + g];
  const float* Dk = p.ssm_d + l * 512 + g * 16;
  hf* Y = (hf*)(ws + OFF_YGELU);
  auto af = [&](int r, int k) { return A + (size_t)r * 384 + k; };
  auto bf = [&](int n, int k) { return Bt + (size_t)n * 384 + k; };
  auto ef = [&](int r, int c0, f4 v) {
    const int R = mt * 128 + r, n = nt * 64 + c0, li = n >> 4, co = n & 15;
    const h4 u = *(const h4*)(A + (size_t)r * 384 + n);
    const f4 dd = *(const f4*)(Dk + co); f4 o;
#pragma unroll
    for (int jj = 0; jj < 4; ++jj) o[jj] = gelu_tanh(dt * v[jj] + dd[jj] * (float)u[jj]);
    *(h4*)(Y + ((size_t)R * 16 + li) * 512 + g * 16 + co) = pack4(o);
  };
  sgemm_tile<2>(384, af, bf, ef, smem);
}

DEVI void ssm_ab(const P& p, int l, int g, int b, char* smem) {
  char* ws = p.ws;
  float* SPL = (float*)(smem + 65536);
  const hf* A = (const hf*)(ws + OFF_USSM) + ((size_t)g * 1024 + b * 128) * 384;
  for (int nt = 0; nt < 2; ++nt) {
    const hf* Bt = (const hf*)(ws + OFF_W1) + ((size_t)g * 128 + nt * 64) * 256;
    auto af = [&](int r, int k) { return A + (size_t)r * 384 + k; };
    auto bf = [&](int n, int k) { return Bt + (size_t)n * 256 + k; };
    auto ef = [&](int r, int c0, f4 v) { *(f4*)(SPL + r * 128 + nt * 64 + c0) = v; };
    sgemm_tile<2>(256, af, bf, ef, smem);
  }
  __syncthreads();
  {
    const int tid = otid(), pp = tid & 63, seg = __builtin_amdgcn_readfirstlane(tid >> 6), c0 = seg * 16;
    const f2 lam = *(const f2*)((const float*)(ws + OFF_LAM16) + (g * 64 + pp) * 2);
    float lr[16], li[16];
    float hr = 0.f, hi = 0.f;
#pragma unroll
    for (int i = 0; i < 16; ++i) {
      lr[i] = hr; li[i] = hi;
      const float sr = SPL[(c0 + i) * 128 + pp], si = SPL[(c0 + i) * 128 + 64 + pp];
      const float nr = lam[0] * hr - lam[1] * hi + sr, ni = lam[0] * hi + lam[1] * hr + si;
      hr = nr; hi = ni;
    }
    f2* E = (f2*)smem;
    E[seg * 64 + pp] = (f2){hr, hi};
    float qr = lam[0], qi = lam[1];
#pragma unroll
    for (int s = 0; s < 4; ++s) { const float tr = qr * qr - qi * qi, ti = 2.f * qr * qi; qr = tr; qi = ti; }
    __syncthreads();
    float Hr = 0.f, Hi = 0.f;
    for (int s = 0; s < seg; ++s) { const f2 e = E[s * 64 + pp]; const float tr = qr * Hr - qi * Hi + e[0], ti = qr * Hi + qi * Hr + e[1]; Hr = tr; Hi = ti; }
    hf* U = (hf*)(ws + OFF_USSM) + ((size_t)g * 1024 + b * 128 + c0) * 384;
    float pr = 1.f, pi = 0.f;
#pragma unroll
    for (int i = 0; i < 16; ++i) {
      const float outr = lr[i] + pr * Hr - pi * Hi, outi = li[i] + pr * Hi + pi * Hr;
      U[(size_t)i * 384 + 256 + pp] = (hf)outr; U[(size_t)i * 384 + 320 + pp] = (hf)outi;
      const float tr = pr * lam[0] - pi * lam[1], ti = pr * lam[1] + pi * lam[0]; pr = tr; pi = ti;
    }
  }
  __syncthreads();
}

DEVI void phase_2(const P& p, int l, char* smem) {
  char* ws = p.ws;
  const int G = gridDim.x;
  for (int it = obid(); it < 256; it += G) {
    const int nt = it & 3, mt = (it >> 2) & 15, jh = it >> 6, j = jh >> 1, h = jh & 1;
    const hf* src = (const hf*)(ws + OFF_KV + (size_t)j * SZ_KV1) + (size_t)h * T_ * 64;
    const hf* Bt = (const hf*)(ws + OFF_BTC1) + ((size_t)j * 256 + nt * 64) * 2048;
    const float* cb = (const float*)(ws + OFF_CB1) + j * 256 + nt * 64;
    hf* HG = (hf*)(ws + OFF_HG) + ((size_t)jh * 1024 + mt * 64) * 256 + nt * 64;
    auto af = [&](int r, int k) { const int R = mt * 64 + r, b = R >> 7, n = min(R & 127, 126); return src + ((size_t)b * 2048 + 16 * n) * 64 + k; };
    auto bf = [&](int n, int k) { return Bt + (size_t)n * 2048 + k; };
    auto ef = [&](int r, int c0, f4 v) { const f4 bb = *(const f4*)(cb + c0); f4 o;
#pragma unroll
      for (int jj = 0; jj < 4; ++jj) o[jj] = gelu_tanh(v[jj] + bb[jj]);
      *(h4*)(HG + (size_t)r * 256 + c0) = pack4(o); };
    sgemm_tile<1>(2048, af, bf, ef, smem);
  }
  for (int it = obid(); it < 256; it += G) ssm_ab(p, l, it >> 3, it & 7, smem);
  {
    const hf* U = (const hf*)(ws + OFF_UPOOL); hf* PO = (hf*)(ws + OFF_POOLED);
    const int gtid = obid() * 512 + otid(), gnt = G * 512;
    for (int idx = gtid; idx < T_ * 64; idx += gnt) {
      const int c8 = idx & 63, t = idx >> 6, s = t & (S_ - 1), gi = c8 >> 4, w = 2 << gi;
      const int cnt = min(w, s + 1);
      float sum[8];
#pragma unroll
      for (int i = 0; i < 8; ++i) sum[i] = 0.f;
      for (int q = 0; q < cnt; ++q) { const h8 v = *(const h8*)(U + (size_t)(t - q) * 512 + c8 * 8);
#pragma unroll
        for (int i = 0; i < 8; ++i) sum[i] += (float)v[i]; }
      const h8 cur = *(const h8*)(U + (size_t)t * 512 + c8 * 8);
      const float inv = 1.0f / (float)cnt;
      h8 o;
#pragma unroll
      for (int i = 0; i < 8; ++i) o[i] = (hf)(sum[i] * inv - (float)cur[i]);
      *(h8*)(PO + (size_t)t * 512 + c8 * 8) = o;
    }
  }
}

DEVI void phase_3(const P& p, int l, char* smem) {
  char* ws = p.ws;
  const int G = gridDim.x;
  for (int it = obid(); it < 1024; it += G) ssm_c_tile(p, l, it >> 5, (it >> 2) & 7, it & 3, smem);
  for (int it = G - 1 - obid(); it < 32; it += G) {
    const int mt = it & 7, jh = it >> 3, j = jh >> 1, h = jh & 1;
    const hf* A = (const hf*)(ws + OFF_HG) + ((size_t)jh * 1024 + mt * 128) * 256;
    const hf* Bt = (const hf*)(ws + OFF_BTC2) + (size_t)j * 64 * 256;
    hf* KC = (hf*)(ws + OFF_KCOMP);
    auto af = [&](int r, int k) { return A + (size_t)r * 256 + k; };
    auto bf = [&](int n, int k) { return Bt + (size_t)n * 256 + k; };
    auto ef = [&](int r, int c0, f4 v) { const int R = mt * 128 + r, b = R >> 7, n = R & 127; *(h4*)(KC + ((((size_t)j * 8 + b) * 2 + h) * 128 + n) * 64 + c0) = pack4(v); };
    sgemm_tile<2>(256, af, bf, ef, smem);
  }
  for (int it = obid(); it < 1024; it += G) {
    const int nt = it & 1, gi = (it >> 1) & 3, mt = it >> 3;
    const hf* A = (const hf*)(ws + OFF_POOLED) + (size_t)mt * 128 * 512 + gi * 128;
    const hf* Bt = (const hf*)(ws + OFF_BTPOOL) + ((size_t)gi * 128 + nt * 64) * 128;
    const float* sc = p.pool_scale + l * 512 + gi * 128 + nt * 64;
    hf* Y = (hf*)(ws + OFF_YBR) + (size_t)mt * 128 * 1536 + 512 + gi * 128 + nt * 64;
    auto af = [&](int r, int k) { return A + (size_t)r * 512 + k; };
    auto bf = [&](int n, int k) { return Bt + (size_t)n * 128 + k; };
    auto ef = [&](int r, int c0, f4 v) { const f4 s4 = *(const f4*)(sc + c0); *(h4*)(Y + (size_t)r * 1536 + c0) = pack4(v * s4); };
    sgemm_tile<2>(128, af, bf, ef, smem);
  }
}


DEVI int crow16(int i, int hh) { return (i & 3) + 8 * (i >> 2) + 4 * hh; }
constexpr float LOG2E = 1.4426950408889634f;

struct NsaCtx {
  hf* Kb; hf* Vb; int tid, w, lane, l32, hh;
  h8 qf[4];
};
DEVI void nsa_stage_load(const NsaCtx& c, const hf* kt, const hf* vt, h8& kr, h8& vr) {
  kr = *(const h8*)(kt + (c.tid >> 3) * 64 + (c.tid & 7) * 8);
  vr = *(const h8*)(vt + c.lane * 64 + c.w * 8);
}
DEVI void nsa_stage_store(const NsaCtx& c, int buf, const h8& kr, const h8& vr) {
  *(h8*)(c.Kb + buf * 4608 + (c.tid >> 3) * 72 + (c.tid & 7) * 8) = kr;
#pragma unroll
  for (int i = 0; i < 8; ++i) c.Vb[buf * 4608 + (c.w * 8 + i) * 68 + c.lane] = vr[i];
}
DEVI void nsa_compute_s(const NsaCtx& c, int buf, f16v (&s)[2]) {
#pragma unroll
  for (int kt = 0; kt < 2; ++kt) {
#pragma unroll
    for (int i = 0; i < 16; ++i) s[kt][i] = 0.f;
#pragma unroll
    for (int st = 0; st < 4; ++st) {
      const h8 a = *(const h8*)(c.Kb + buf * 4608 + (kt * 32 + c.l32) * 72 + st * 16 + c.hh * 8);
      s[kt] = __builtin_amdgcn_mfma_f32_32x32x16_f16(a, c.qf[st], s[kt], 0, 0, 0);
    }
  }
}
DEVI void nsa_compute_pv(const NsaCtx& c, int buf, const f16v (&pr)[2], f16v (&o)[2]) {
#pragma unroll
  for (int kt = 0; kt < 2; ++kt)
#pragma unroll
    for (int s2 = 0; s2 < 2; ++s2) {
      h8 pb;
#pragma unroll
      for (int j = 0; j < 8; ++j) pb[j] = (hf)pr[kt][8 * s2 + j];
#pragma unroll
      for (int dt = 0; dt < 2; ++dt) {
        const hf* vrow = c.Vb + buf * 4608 + (dt * 32 + c.l32) * 68 + kt * 32 + s2 * 16 + c.hh * 4;
        const h4 lo = *(const h4*)vrow, hi = *(const h4*)(vrow + 8);
        h8 a; a[0] = lo[0]; a[1] = lo[1]; a[2] = lo[2]; a[3] = lo[3]; a[4] = hi[0]; a[5] = hi[1]; a[6] = hi[2]; a[7] = hi[3];
        o[dt] = __builtin_amdgcn_mfma_f32_32x32x16_f16(a, pb, o[dt], 0, 0, 0);
      }
    }
}

template <int MODE>
DEVI void nsa_run(const NsaCtx& c, unsigned tiles, const hf* Kbase, const hf* Vbase, int t, int qb, unsigned selmask, f16v (&o)[2], float& m, float& l) {
  h8 kr, vr;
  int j = __builtin_ctz(tiles); tiles &= tiles - 1;
  nsa_stage_load(c, Kbase + (size_t)j * 4096, Vbase + (size_t)j * 4096, kr, vr);
  __syncthreads();
  nsa_stage_store(c, 0, kr, vr);
  __syncthreads();
  int buf = 0;
  while (true) {
    const bool more = tiles != 0u;
    int jn = 0;
    if (more) { jn = __builtin_ctz(tiles); tiles &= tiles - 1; nsa_stage_load(c, Kbase + (size_t)jn * 4096, Vbase + (size_t)jn * 4096, kr, vr); }
    bool tile_ok = true;
    if (MODE == 1) tile_ok = (selmask >> j) & 1u;
    if (MODE != 1 || __builtin_amdgcn_ballot_w64(tile_ok) != 0ull) {
    f16v s[2];
    nsa_compute_s(c, buf, s);
    const bool edge = (j == qb) || (MODE == 2 && j == qb - 8);
    float mx = -1e30f;
    if (edge) {
#pragma unroll
      for (int kt = 0; kt < 2; ++kt)
#pragma unroll
        for (int i = 0; i < 16; ++i) {
          const int key = j * 64 + kt * 32 + crow16(i, c.hh);
          bool ok = tile_ok && key <= t;
          if (MODE == 2) ok = ok && (t - key < 512);
          const float v = ok ? s[kt][i] : -1e30f;
          s[kt][i] = v; mx = fmaxf(mx, v);
        }
    } else {
#pragma unroll
      for (int kt = 0; kt < 2; ++kt)
#pragma unroll
        for (int i = 0; i < 16; ++i) {
          const float v = (MODE == 2 || tile_ok) ? s[kt][i] : -1e30f;
          s[kt][i] = v; mx = fmaxf(mx, v);
        }
    }
    mx = fmaxf(mx, __shfl_xor(mx, 32));
    const float mn = fmaxf(m, mx), corr = __builtin_amdgcn_exp2f(m - mn);
    m = mn;
    float ls = 0.f;
    if (!edge && (MODE == 2 || j > 0)) {
#pragma unroll
      for (int kt = 0; kt < 2; ++kt)
#pragma unroll
        for (int i = 0; i < 16; ++i) { const float pv = __builtin_amdgcn_exp2f(s[kt][i] - mn); s[kt][i] = pv; ls += pv; }
    } else {
#pragma unroll
      for (int kt = 0; kt < 2; ++kt)
#pragma unroll
        for (int i = 0; i < 16; ++i) { const float pv = s[kt][i] > -1e29f ? __builtin_amdgcn_exp2f(s[kt][i] - mn) : 0.f; s[kt][i] = pv; ls += pv; }
    }
    l = l * corr + ls;
    if (__builtin_amdgcn_ballot_w64(corr != 1.0f) != 0ull) {
#pragma unroll
      for (int dt = 0; dt < 2; ++dt)
#pragma unroll
        for (int i = 0; i < 16; ++i) o[dt][i] *= corr;
    }
    nsa_compute_pv(c, buf, s, o);
    }
    if (more) nsa_stage_store(c, buf ^ 1, kr, vr);
    __syncthreads();
    if (!more) break;
    buf ^= 1; j = jn;
  }
}

DEVI void nsa_item(const P& p, int b, int hkv, int qb, char* smem) {
  char* ws = p.ws;
  NsaCtx c;
  c.Kb = (hf*)smem; c.Vb = (hf*)(smem + 2 * 9216);
  unsigned* maskw = (unsigned*)(smem + 36864);
  float* score = (float*)(smem + 36864 + 256);
  float* impP = (float*)(smem + 36864 + 256 + 8448);
  c.tid = otid(); c.w = __builtin_amdgcn_readfirstlane(c.tid >> 6); c.lane = c.tid & 63; c.l32 = c.lane & 31; c.hh = c.lane >> 5;
  const int g = c.w >> 1, half = c.w & 1, tl = half * 32 + c.l32, t = qb * 64 + tl, tg = b * S_ + t, head = hkv * 4 + g;
  {
    const hf* Qp = (const hf*)(ws + OFF_Q) + (size_t)tg * 512 + head * 64 + c.hh * 8;
#pragma unroll
    for (int st = 0; st < 4; ++st) { h8 q = *(const h8*)(Qp + st * 16);
#pragma unroll
      for (int i = 0; i < 8; ++i) q[i] = (hf)((float)q[i] * (0.125f * LOG2E));
      c.qf[st] = q; }
  }
  const float* NG = (const float*)(ws + OFF_NSAG) + (size_t)tg * 24;
  const float g_cmp = NG[head], g_sel = NG[8 + head], g_win = NG[16 + head];
  f16v fin[2];
  {
    const hf* Kc = (const hf*)(ws + OFF_KCOMP) + (((size_t)0 * 8 + b) * 2 + hkv) * 128 * 64;
    const hf* Vc = (const hf*)(ws + OFF_KCOMP) + (((size_t)1 * 8 + b) * 2 + hkv) * 128 * 64;
    h8 kr, vr, kr1, vr1;
    nsa_stage_load(c, Kc, Vc, kr, vr); nsa_stage_load(c, Kc + 4096, Vc + 4096, kr1, vr1);
    __syncthreads();
    nsa_stage_store(c, 0, kr, vr); nsa_stage_store(c, 1, kr1, vr1);
    __syncthreads();
    f16v s0[2], s1[2];
    nsa_compute_s(c, 0, s0); nsa_compute_s(c, 1, s1);
    float mx = -1e30f;
#pragma unroll
    for (int kt = 0; kt < 2; ++kt)
#pragma unroll
      for (int i = 0; i < 16; ++i) {
        const int n0 = kt * 32 + crow16(i, c.hh), n1 = 64 + n0;
        const float v0 = (16 * n0 + 31 <= t) ? s0[kt][i] : -1e30f, v1 = (16 * n1 + 31 <= t) ? s1[kt][i] : -1e30f;
        s0[kt][i] = v0; s1[kt][i] = v1; mx = fmaxf(mx, fmaxf(v0, v1));
      }
    mx = fmaxf(mx, __shfl_xor(mx, 32));
    float ls = 0.f;
#pragma unroll
    for (int kt = 0; kt < 2; ++kt)
#pragma unroll
      for (int i = 0; i < 16; ++i) {
        const float p0 = s0[kt][i] > -1e29f ? __builtin_amdgcn_exp2f(s0[kt][i] - mx) : 0.f, p1 = s1[kt][i] > -1e29f ? __builtin_amdgcn_exp2f(s1[kt][i] - mx) : 0.f;
        s0[kt][i] = p0; s1[kt][i] = p1; ls += p0 + p1;
      }
    ls += __shfl_xor(ls, 32);
    const float inv = ls > 0.f ? 1.0f / ls : 0.f;
#pragma unroll
    for (int kt = 0; kt < 2; ++kt)
#pragma unroll
      for (int i = 0; i < 16; ++i) { s0[kt][i] *= inv; s1[kt][i] *= inv; }
    float* ip = impP + (g * 64 + tl) * 33;
#pragma unroll
    for (int kt = 0; kt < 2; ++kt)
#pragma unroll
      for (int q = 0; q < 4; ++q) {
        const int j0 = kt * 8 + q * 2 + c.hh;
        ip[j0] = s0[kt][4 * q] + s0[kt][4 * q + 1] + s0[kt][4 * q + 2] + 0.5f * s0[kt][4 * q + 3];
        ip[16 + j0] = s1[kt][4 * q] + s1[kt][4 * q + 1] + s1[kt][4 * q + 2] + 0.5f * s1[kt][4 * q + 3];
      }
    __syncthreads();
#pragma unroll
    for (int kt = 0; kt < 2; ++kt)
#pragma unroll
      for (int q = 0; q < 4; ++q) {
        const int j0 = kt * 8 + q * 2 + c.hh;
        ip[j0 + 1] += 0.5f * s0[kt][4 * q + 3];
        if (16 + j0 + 1 < 32) ip[16 + j0 + 1] += 0.5f * s1[kt][4 * q + 3];
      }
#pragma unroll
    for (int dt = 0; dt < 2; ++dt)
#pragma unroll
      for (int i = 0; i < 16; ++i) fin[dt][i] = 0.f;
    nsa_compute_pv(c, 0, s0, fin); nsa_compute_pv(c, 1, s1, fin);
#pragma unroll
    for (int dt = 0; dt < 2; ++dt)
#pragma unroll
      for (int i = 0; i < 16; ++i) fin[dt][i] *= g_cmp;
    __syncthreads();
  }
  for (int idx = c.tid; idx < 2048; idx += 512) {
    const int tok = idx >> 5, j = idx & 31;
    const float imp = ((impP[(0 * 64 + tok) * 33 + j] + impP[(1 * 64 + tok) * 33 + j]) + impP[(2 * 64 + tok) * 33 + j]) + impP[(3 * 64 + tok) * 33 + j];
    const bool forced = (j == 0) || (j == qb) || (j == qb - 1);
    score[tok * 33 + j] = forced ? 1e30f : (j <= qb ? imp : -1e30f);
  }
  if (c.tid < 64) maskw[c.tid] = 0u;
  __syncthreads();
  for (int idx = c.tid; idx < 2048; idx += 512) {
    const int tok = idx >> 5, j = idx & 31;
    const float sj = score[tok * 33 + j];
    int rank = 0;
    for (int jj = 0; jj < 32; ++jj) { const float o = score[tok * 33 + jj]; rank += (o > sj || (o == sj && jj < j)) ? 1 : 0; }
    if (rank < 16 && sj > -1e29f) atomicOr(&maskw[tok], 1u << j);
  }
  __syncthreads();
  const unsigned selmask = maskw[tl];
  unsigned anym = 0u;
  for (int i = 0; i < 64; ++i) anym |= maskw[i];
  {
    f16v o[2];
#pragma unroll
    for (int dt = 0; dt < 2; ++dt)
#pragma unroll
      for (int i = 0; i < 16; ++i) o[dt][i] = 0.f;
    float m = -1e30f, l = 0.f;
    const hf* Kb = (const hf*)(ws + OFF_KV + 2 * SZ_KV1) + ((size_t)hkv * T_ + (size_t)b * S_) * 64;
    const hf* Vb = (const hf*)(ws + OFF_KV + 3 * SZ_KV1) + ((size_t)hkv * T_ + (size_t)b * S_) * 64;
    nsa_run<1>(c, anym, Kb, Vb, t, qb, selmask, o, m, l);
    l += __shfl_xor(l, 32);
    const float sc = l > 0.f ? g_sel / l : 0.f;
#pragma unroll
    for (int dt = 0; dt < 2; ++dt)
#pragma unroll
      for (int i = 0; i < 16; ++i) fin[dt][i] += o[dt][i] * sc;
  }
  {
    f16v o[2];
#pragma unroll
    for (int dt = 0; dt < 2; ++dt)
#pragma unroll
      for (int i = 0; i < 16; ++i) o[dt][i] = 0.f;
    float m = -1e30f, l = 0.f;
    const hf* Kb = (const hf*)(ws + OFF_KV + 4 * SZ_KV1) + ((size_t)hkv * T_ + (size_t)b * S_) * 64;
    const hf* Vb = (const hf*)(ws + OFF_KV + 5 * SZ_KV1) + ((size_t)hkv * T_ + (size_t)b * S_) * 64;
    const int jlo = max(qb - 8, 0);
    const unsigned tiles = (unsigned)((((unsigned long long)2 << qb) - 1ull) & ~((1ull << jlo) - 1ull));
    nsa_run<2>(c, tiles, Kb, Vb, t, qb, 0u, o, m, l);
    l += __shfl_xor(l, 32);
    const float sc = l > 0.f ? g_win / l : 0.f;
#pragma unroll
    for (int dt = 0; dt < 2; ++dt)
#pragma unroll
      for (int i = 0; i < 16; ++i) fin[dt][i] += o[dt][i] * sc;
  }
  hf* Y = (hf*)(ws + OFF_YBR) + (size_t)tg * 1536 + 1024 + head * 64;
#pragma unroll
  for (int dt = 0; dt < 2; ++dt)
#pragma unroll
    for (int q = 0; q < 4; ++q) {
      h4 ov; ov[0] = (hf)fin[dt][4 * q]; ov[1] = (hf)fin[dt][4 * q + 1]; ov[2] = (hf)fin[dt][4 * q + 2]; ov[3] = (hf)fin[dt][4 * q + 3];
      *(h4*)(Y + dt * 32 + q * 8 + c.hh * 4) = ov;
    }
}

DEVI void phase_4(const P& p, int l, char* smem) {
  for (int pi = obid(); pi < 256; pi += gridDim.x) {
    const int b = pi >> 5, hkv = (pi >> 4) & 1, x = pi & 15;
#pragma unroll 1
    for (int k = 0; k < 2; ++k) nsa_item(p, b, hkv, k ? x : 31 - x, smem);
  }
}

#ifndef REPW
#define REPW 1
#endif
#ifndef REP1
#define REP1 1
#endif
#ifndef REP2
#define REP2 1
#endif
#ifndef REP3
#define REP3 1
#endif
#ifndef REP4
#define REP4 1
#endif
#ifndef REP5
#define REP5 1
#endif
#ifndef REP6
#define REP6 1
#endif
#ifndef REP9
#define REP9 1
#endif
#ifndef XSYNC
#define XSYNC 0
#endif
DEVI const P& getp() {
  const __attribute__((address_space(4))) char* k = (const __attribute__((address_space(4))) char*)__builtin_amdgcn_kernarg_segment_ptr();
  asm volatile("" : "+s"(k));
  return *(const P*)k;
}
__global__ void __launch_bounds__(512) mega(P p_unused) {
  cg::grid_group grid = cg::this_grid();
  __shared__ __attribute__((aligned(16))) char smem[131072];
  __shared__ uint4 xb_words;
  if (threadIdx.x == 0) xb_words = make_uint4(0u, 0u, 0u, 0u);
  __syncthreads();
  (void)xcd_barrier_post((unsigned*)(getp().ws + OFF_BAR), (volatile LAS unsigned*)&xb_words);
#define GSYNC() do { XcdBarrier xb_; xb_.bar = (unsigned*)(getp().ws + OFF_BAR); xb_.x = xb_xcc_id(); xb_.st = (volatile LAS unsigned*)&xb_words; xcd_barrier(xb_); } while (0)
  phase_0(getp());
  grid.sync();
  for (int r = 0; r < XSYNC; ++r) GSYNC();
#pragma unroll 1
  for (int ll = 0; ll < DEPTH_; ++ll) {
    int l = ll; asm volatile("" : "+s"(l));
    if (l == 0) { phase_w(getp(), 0, smem); GSYNC(); }
    { const P& p = getp(); EpiIn e{p.ws}; for (int r = 0; r < REP1; ++r) { gemm256((const hf*)(p.ws + OFF_XH), 1024, (const hf*)(p.ws + OFF_BTIN), 1024, 1024, 64, 10, smem, e, NoHook()); GSYNC(); } }
    phase_2(getp(), l, smem);
    w_ffo(getp(), l, smem);
    GSYNC();
    for (int r = 0; r < REP3; ++r) { phase_3(getp(), l, smem); GSYNC(); }
    phase_4(getp(), l, smem);
    { const P& p = getp(); EpiGlu e{(hf*)(p.ws + OFF_YBR)}; gemm256((const hf*)(p.ws + OFF_YGELU), 512, (const hf*)(p.ws + OFF_BTGLU), 512, 512, 64, 4, smem, e, NoHook()); }
    { const P& p = getp(); EpiGate e{(unsigned char*)(p.ws + OFF_BRG)}; gemm256((const hf*)(p.ws + OFF_XH), 1024, (const hf*)(p.ws + OFF_BTIN) + NINA * 1024, 1024, 1024, 64, 12, smem, e, NoHook()); }
    GSYNC();
    { const P& p = getp(); HookMerge h{(const unsigned char*)(p.ws + OFF_BRG)}; EpiMerge e{(const unsigned char*)(p.ws + OFF_BRG), (hf*)(p.ws + OFF_MERGED)};
      for (int r = 0; r < REP6; ++r) { gemm256((const hf*)(p.ws + OFF_YBR), 1536, (const hf*)(p.ws + OFF_BTBR), 1536, 1536, 64, 4, smem, e, h); GSYNC(); } }
    { const P& p = getp(); EpiRes e{nullptr, (const hf*)(p.ws + OFF_XH), nullptr, (hf*)(p.ws + OFF_XH), p.ln_g + (l * 2 + 0) * 1024, p.ln_b + (l * 2 + 0) * 1024,
                                   (unsigned long long*)(p.ws + OFF_XS), (unsigned*)(p.ws + OFF_BAR + 16384), 16u * (unsigned)(2 * l + 1), smem};
      gemm256((const hf*)(p.ws + OFF_MERGED), 1024, (const hf*)(p.ws + OFF_BTWO), 1024, 1024, 64, 4, smem, e, NoHook()); }
    GSYNC();
    { const P& p = getp(); EpiSwiglu e{(hf*)(p.ws + OFF_HFF)}; for (int r = 0; r < REP9; ++r) { gemm256((const hf*)(p.ws + OFF_XH), 1024, (const hf*)(p.ws + OFF_BTFI), 1024, 1024, 64, 22, smem, e, NoHook()); GSYNC(); } }
    { const P& p = getp(); EpiRes e{nullptr, (const hf*)(p.ws + OFF_XH), l == DEPTH_ - 1 ? p.out : nullptr, l == DEPTH_ - 1 ? nullptr : (hf*)(p.ws + OFF_XH), p.ln_g + (l * 2 + 1) * 1024, p.ln_b + (l * 2 + 1) * 1024,
                                   (unsigned long long*)(p.ws + OFF_XS), (unsigned*)(p.ws + OFF_BAR + 16384), 16u * (unsigned)(2 * l + 2), smem};
      gemm256((const hf*)(p.ws + OFF_HFF), FFH, (const hf*)(p.ws + OFF_BTFO), FFH, FFH, 64, 4, smem, e, NoHook()); }
    if (l + 1 < DEPTH_) phase_w(getp(), l + 1, smem);
    GSYNC();
  }
}

extern "C" void kernel_launch(void* const* d_in, const int* in_sizes, int n_in, void* d_out, int out_size, void* d_ws, size_t ws_size, hipStream_t stream) {
  static int grid_blocks = 0;
  if (!grid_blocks) {
    int dev = 0, cus = 0, per = 0;
    hipGetDevice(&dev);
    hipDeviceGetAttribute(&cus, hipDeviceAttributeMultiprocessorCount, dev);
    hipOccupancyMaxActiveBlocksPerMultiprocessor(&per, mega, 512, 0);
    if (per < 1) per = 1;
    if (per > 1) per = 1;
    grid_blocks = cus * per;
  }
  P p{};
  p.x = (const float*)d_in[0]; p.pos = (const int*)d_in[1]; p.w_in = (const float*)d_in[2]; p.a_re = (const float*)d_in[3]; p.a_im = (const float*)d_in[4];
  p.log_dt = (const float*)d_in[5]; p.b_re = (const float*)d_in[6]; p.b_im = (const float*)d_in[7]; p.c_re = (const float*)d_in[8]; p.c_im = (const float*)d_in[9];
  p.ssm_d = (const float*)d_in[10]; p.w_glu = (const float*)d_in[11]; p.pool_w = (const float*)d_in[12]; p.pool_scale = (const float*)d_in[13];
  p.cmp_pos = (const float*)d_in[14]; p.cmp_w1 = (const float*)d_in[15]; p.cmp_b1 = (const float*)d_in[16]; p.cmp_w2 = (const float*)d_in[17];
  p.w_branch = (const float*)d_in[18]; p.w_out = (const float*)d_in[19]; p.ln_g = (const float*)d_in[20]; p.ln_b = (const float*)d_in[21];
  p.ffn_w_in = (const float*)d_in[22]; p.ffn_w_out = (const float*)d_in[23];
  p.out = (float*)d_out; p.ws = (char*)d_ws;
  hipMemsetAsync((char*)d_ws + OFF_BAR, 0, 32768, stream);
  void* args[] = {&p};
  hipError_t e = hipLaunchCooperativeKernel((void*)mega, dim3(grid_blocks), dim3(512), args, 0, stream);
  if (e != hipSuccess) fprintf(stderr, "cooperative launch failed: %s (grid %d)\n", hipGetErrorString(e), grid_blocks);
}
```
